# Optimizing an MI355X kernel written in HIP

```python
import math
import jax, jax.numpy as jnp
from jax import lax
import numpy as np

D_MODEL = 1024
BATCH = 4
SEQ = 4096
DEPTH = 1

HEAD_DIM = 64
ATTN_SCALE = HEAD_DIM ** -0.5
SWA_Q_HEADS = 8
SWA_KV_HEADS = 2
SWA_GROUP = SWA_Q_HEADS // SWA_KV_HEADS
SWA_WINDOW = 128
SWA_BLOCK = 128
MOBA_HEADS = 8
MOBA_BLOCK = 256
MOBA_TOPK = 3
MOBA_Q_CHUNK = 32
NUM_BUCKETS = 32
MAX_EXACT = NUM_BUCKETS // 2
MAX_DISTANCE = 2048
N_ATTN_HEADS = SWA_Q_HEADS + MOBA_HEADS
SWA_Q_W = SWA_Q_HEADS * HEAD_DIM
SWA_KV_W = SWA_KV_HEADS * HEAD_DIM
MOBA_W = MOBA_HEADS * HEAD_DIM
N_BRANCHES = 2
IN_WIDTHS = (SWA_Q_W, SWA_KV_W, SWA_KV_W, MOBA_W, MOBA_W, MOBA_W, D_MODEL, D_MODEL)
IN_TOTAL = SWA_Q_W + 2 * SWA_KV_W + 3 * MOBA_W + N_BRANCHES * D_MODEL
D_FF = 4 * D_MODEL
N_MOD = 6
RMS_EPS = 1e-6

kernel_name = "hybrid_swa_moba_gated_adaln_block"


def rmsnorm(x, g):
    xf = x.astype(jnp.float32)
    y = xf * lax.rsqrt(jnp.mean(xf * xf, axis=-1, keepdims=True) + RMS_EPS)
    return (y * g.astype(jnp.float32)).astype(x.dtype)


def modulate(h, shift, scale):
    return h * (1.0 + scale[:, None, :]) + shift[:, None, :]


def t5_bucket(dist):
    n = jnp.maximum(dist, 0)
    nf = jnp.maximum(n, 1).astype(jnp.float32)
    large = MAX_EXACT + (jnp.log(nf / MAX_EXACT) / math.log(MAX_DISTANCE / MAX_EXACT)
                         * (NUM_BUCKETS - MAX_EXACT)).astype(jnp.int32)
    large = jnp.minimum(large, NUM_BUCKETS - 1)
    return jnp.where(n < MAX_EXACT, n, large)


def swa_attention(q, k, v, sinks, rel_bias):
    B, S = q.shape[0], q.shape[1]
    L = SWA_BLOCK
    nb = S // L
    qb = q.reshape(B, nb, L, SWA_KV_HEADS, SWA_GROUP, HEAD_DIM)
    kb = k.reshape(B, nb, L, SWA_KV_HEADS, HEAD_DIM)
    vb = v.reshape(B, nb, L, SWA_KV_HEADS, HEAD_DIM)
    pad = ((0, 0), (1, 0), (0, 0), (0, 0), (0, 0))
    kk = jnp.concatenate([jnp.pad(kb, pad)[:, :-1], kb], axis=2)
    vv = jnp.concatenate([jnp.pad(vb, pad)[:, :-1], vb], axis=2)
    s = jnp.einsum('bnqhgd,bnkhd->bnhgqk', qb, kk).astype(jnp.float32) * ATTN_SCALE
    i = jnp.arange(L)[:, None] + L
    j = jnp.arange(2 * L)[None, :]
    dist = i - j
    bias = rel_bias[t5_bucket(dist)][..., :SWA_Q_HEADS].astype(jnp.float32)
    bias = bias.transpose(2, 0, 1).reshape(SWA_KV_HEADS, SWA_GROUP, L, 2 * L)
    kabs = jnp.arange(nb)[:, None, None] * L - L + j[None]
    mask = ((dist >= 0) & (dist < SWA_WINDOW))[None] & (kabs >= 0)
    s = jnp.where(mask[None, :, None, None], s + bias, -jnp.inf)
    sink = sinks.astype(jnp.float32).reshape(SWA_KV_HEADS, SWA_GROUP)[None, None, :, :, None, None]
    m = jnp.maximum(jnp.max(s, axis=-1, keepdims=True), sink)
    p = jnp.exp(s - m)
    p = p / (jnp.sum(p, axis=-1, keepdims=True) + jnp.exp(sink - m))
    o = jnp.einsum('bnhgqk,bnkhd->bnqhgd', p.astype(v.dtype), vv)
    return o.reshape(B, S, SWA_Q_HEADS * HEAD_DIM)


def moba_attention(q, k, v, rel_bias):
    B, S = q.shape[0], q.shape[1]
    H = MOBA_HEADS
    MB = MOBA_BLOCK
    nblk = (S + MB - 1) // MB
    Sp = nblk * MB
    k_eff = max(1, min(MOBA_TOPK, nblk - 1))
    padw = ((0, 0), (0, Sp - S), (0, 0), (0, 0))
    q = jnp.pad(q, padw)
    k = jnp.pad(k, padw)
    v = jnp.pad(v, padw)
    qh = q.transpose(0, 2, 1, 3)
    kb = k.reshape(B, nblk, MB, H, HEAD_DIM).transpose(0, 3, 1, 2, 4)
    vb = v.reshape(B, nblk, MB, H, HEAD_DIM).transpose(0, 3, 1, 2, 4)
    kmean = jnp.mean(kb.astype(jnp.float32), axis=3)
    gate = jnp.einsum('bhsd,bhnd->bhsn', qh.astype(jnp.float32), kmean)
    qblk = jnp.arange(Sp) // MB
    past = jnp.arange(nblk)[None, :] < qblk[:, None]
    gate = jnp.where(past, gate, -jnp.inf)
    _, idx = lax.top_k(gate, k_eff)
    valid = jnp.arange(k_eff)[None, :] < qblk[:, None]
    table_b = rel_bias[:, SWA_Q_HEADS:].T.astype(jnp.float32)
    bi = jnp.arange(B)[:, None, None, None]
    hi = jnp.arange(H)[None, :, None, None]
    hi5 = hi[..., None]
    n_chunks = Sp // MOBA_Q_CHUNK

    def chunk_fn(ci):
        start = ci * MOBA_Q_CHUNK
        q_c = lax.dynamic_slice_in_dim(qh, start, MOBA_Q_CHUNK, axis=2)
        idx_c = lax.dynamic_slice_in_dim(idx, start, MOBA_Q_CHUNK, axis=2)
        valid_c = lax.dynamic_slice_in_dim(valid, start, MOBA_Q_CHUNK, axis=0)
        qpos = start + jnp.arange(MOBA_Q_CHUNK)
        own = start // MB
        k_sel = kb[bi, hi, idx_c]
        v_sel = vb[bi, hi, idx_c]
        s_past = jnp.einsum('bhqd,bhqrkd->bhqrk', q_c, k_sel).astype(jnp.float32) * ATTN_SCALE
        kpos_past = idx_c[..., None] * MB + jnp.arange(MB)
        bias_past = table_b[hi5, t5_bucket(qpos[:, None, None] - kpos_past)]
        s_past = jnp.where(valid_c[None, None, :, :, None], s_past + bias_past, -jnp.inf)
        s_past = s_past.reshape(B, H, MOBA_Q_CHUNK, k_eff * MB)
        k_own = lax.dynamic_index_in_dim(kb, own, axis=2, keepdims=False)
        v_own = lax.dynamic_index_in_dim(vb, own, axis=2, keepdims=False)
        s_own = jnp.einsum('bhqd,bhkd->bhqk', q_c, k_own).astype(jnp.float32) * ATTN_SCALE
        dist_own = qpos[:, None] - (own * MB + jnp.arange(MB))[None, :]
        bias_own = table_b[:, t5_bucket(dist_own)]
        s_own = jnp.where(dist_own >= 0, s_own + bias_own, -jnp.inf)
        p = jax.nn.softmax(jnp.concatenate([s_past, s_own], axis=-1), axis=-1)
        p_past = p[..., :k_eff * MB].reshape(B, H, MOBA_Q_CHUNK, k_eff, MB)
        p_own = p[..., k_eff * MB:]
        o = (jnp.einsum('bhqrk,bhqrkd->bhqd', p_past.astype(v_sel.dtype), v_sel)
             + jnp.einsum('bhqk,bhkd->bhqd', p_own.astype(v_own.dtype), v_own))
        return o

    out = lax.map(chunk_fn, jnp.arange(n_chunks))
    out = out.transpose(1, 0, 3, 2, 4).reshape(B, Sp, H * HEAD_DIM)
    return out[:, :S]


def setup_inputs(seed: int = 0) -> dict:
    key = jax.random.key(seed)
    ks = jax.random.split(key, 16)
    f32 = jnp.float32
    nrm = lambda k, shape, s: jax.random.normal(k, shape, f32) * s
    return {
        "x": nrm(ks[0], (BATCH, SEQ, D_MODEL), 1.0),
        "c": nrm(ks[1], (BATCH, D_MODEL), 1.0),
        "ada_w": nrm(ks[2], (DEPTH, D_MODEL, N_MOD * D_MODEL), D_MODEL ** -0.5),
        "ada_b": nrm(ks[3], (DEPTH, N_MOD * D_MODEL), 0.02),
        "norm1_g": 1.0 + nrm(ks[4], (DEPTH, D_MODEL), 0.02),
        "norm2_g": 1.0 + nrm(ks[5], (DEPTH, D_MODEL), 0.02),
        "w_in": nrm(ks[6], (DEPTH, D_MODEL, IN_TOTAL), D_MODEL ** -0.5),
        "attn_sinks": nrm(ks[7], (DEPTH, SWA_Q_HEADS), 0.5),
        "rel_bias": nrm(ks[8], (NUM_BUCKETS, N_ATTN_HEADS), 0.5),
        "w_branch_a": nrm(ks[9], (DEPTH, SWA_Q_W, D_MODEL), SWA_Q_W ** -0.5),
        "w_branch_b": nrm(ks[10], (DEPTH, MOBA_W, D_MODEL), MOBA_W ** -0.5),
        "w_out": nrm(ks[11], (DEPTH, D_MODEL, D_MODEL), D_MODEL ** -0.5),
        "w_mlp_in": nrm(ks[12], (DEPTH, D_MODEL, D_FF), D_MODEL ** -0.5),
        "w_mlp_out": nrm(ks[13], (DEPTH, D_FF, D_MODEL), D_FF ** -0.5),
        "final_g": 1.0 + nrm(ks[14], (D_MODEL,), 0.02),
    }


def reference(x, c, ada_w, ada_b, norm1_g, norm2_g, w_in, attn_sinks, rel_bias,
              w_branch_a, w_branch_b, w_out, w_mlp_in, w_mlp_out, final_g):
    B, S = x.shape[0], x.shape[1]
    offsets = []
    acc = 0
    for w in IN_WIDTHS[:-1]:
        acc += w
        offsets.append(acc)
    cs = jax.nn.silu(c)
    for l in range(DEPTH):
        mod = cs @ ada_w[l] + ada_b[l]
        shift1, scale1, gate1, shift2, scale2, gate2 = jnp.split(mod, N_MOD, axis=-1)
        h = modulate(rmsnorm(x, norm1_g[l]), shift1, scale1)
        proj = h @ w_in[l]
        qa, ka, va, qb, kb, vb, ga, gb = jnp.split(proj, offsets, axis=-1)
        ya = swa_attention(qa.reshape(B, S, SWA_Q_HEADS, HEAD_DIM),
                           ka.reshape(B, S, SWA_KV_HEADS, HEAD_DIM),
                           va.reshape(B, S, SWA_KV_HEADS, HEAD_DIM),
                           attn_sinks[l], rel_bias) @ w_branch_a[l]
        yb = moba_attention(qb.reshape(B, S, MOBA_HEADS, HEAD_DIM),
                            kb.reshape(B, S, MOBA_HEADS, HEAD_DIM),
                            vb.reshape(B, S, MOBA_HEADS, HEAD_DIM),
                            rel_bias) @ w_branch_b[l]
        merged = jax.nn.sigmoid(ga) * ya + jax.nn.sigmoid(gb) * yb
        x = x + gate1[:, None, :] * (merged @ w_out[l])
        h2 = modulate(rmsnorm(x, norm2_g[l]), shift2, scale2)
        y = jnp.square(jax.nn.relu(h2 @ w_mlp_in[l])) @ w_mlp_out[l]
        x = x + gate2[:, None, :] * y
    return rmsnorm(x, final_g)
```

```cpp
#include <hip/hip_runtime.h>
#include <cstdio>
#include <cstdint>

namespace nv {
constexpr int B = 4, S = 4096, D = 1024, M = B * S, HD = 64;
constexpr int INTOT = 4352, DFF = 4096, NMOD = 6;
constexpr int QKVW = 2304;
constexpr int OFF_QA = 0, OFF_KA = 512, OFF_VA = 640, OFF_QB = 768, OFF_KB = 1280, OFF_VB = 1792, OFF_GA = 2304, OFF_GB = 3328;
constexpr float EPS = 1e-6f;
constexpr size_t MiB = 1u << 20;

__device__ __forceinline__ int t5_bucket(int d) {
    if (d < 16) return d;
    int b = 16;
    b += (d >= 22); b += (d >= 30); b += (d >= 40); b += (d >= 54); b += (d >= 73); b += (d >= 99); b += (d >= 134); b += (d >= 182);
    b += (d >= 246); b += (d >= 332); b += (d >= 450); b += (d >= 609); b += (d >= 825); b += (d >= 1117); b += (d >= 1513);
    return b;
}
__device__ __forceinline__ float wave_sum(float v) {
#pragma unroll
    for (int o = 1; o < 64; o <<= 1) v += __shfl_xor(v, o);
    return v;
}
__device__ __forceinline__ float wave_max(float v) {
#pragma unroll
    for (int o = 1; o < 64; o <<= 1) v = fmaxf(v, __shfl_xor(v, o));
    return v;
}

__global__ void __launch_bounds__(256) k_mod(const float* c, const float* ada_w, const float* ada_b, float* mod) {
    const int n = blockIdx.x * 256 + threadIdx.x;
    float a0 = 0.f, a1 = 0.f, a2 = 0.f, a3 = 0.f;
    for (int k = 0; k < D; ++k) {
        const float w = ada_w[(size_t)k * (NMOD * D) + n];
        const float c0 = c[k], c1 = c[D + k], c2 = c[2 * D + k], c3 = c[3 * D + k];
        a0 += (c0 / (1.f + expf(-c0))) * w; a1 += (c1 / (1.f + expf(-c1))) * w; a2 += (c2 / (1.f + expf(-c2))) * w; a3 += (c3 / (1.f + expf(-c3))) * w;
    }
    const float bb = ada_b[n];
    mod[n] = a0 + bb; mod[NMOD * D + n] = a1 + bb; mod[2 * NMOD * D + n] = a2 + bb; mod[3 * NMOD * D + n] = a3 + bb;
}

__global__ void __launch_bounds__(256) k_norm(const float* x, const float* g, const float* mod, int shift_idx, int scale_idx, float* out) {
    const int row = blockIdx.x * 4 + (threadIdx.x >> 6), lane = threadIdx.x & 63;
    const int b = row / S;
    const float* xr = x + (size_t)row * D;
    float v[16]; float s = 0.f;
#pragma unroll
    for (int j = 0; j < 16; ++j) { v[j] = xr[j * 64 + lane]; s += v[j] * v[j]; }
    s = wave_sum(s);
    const float r = rsqrtf(s * (1.f / D) + EPS);
#pragma unroll
    for (int j = 0; j < 16; ++j) {
        const int d = j * 64 + lane;
        float y = v[j] * r * g[d];
        if (mod) y = y * (1.f + mod[(size_t)b * NMOD * D + scale_idx * D + d]) + mod[(size_t)b * NMOD * D + shift_idx * D + d];
        out[(size_t)row * D + d] = y;
    }
}

template <class Epi>
__global__ void __launch_bounds__(256) k_gemm(const float* __restrict__ A, int lda, const float* __restrict__ Bw, int ldb, int K, Epi E) {
    __shared__ float As[16][132];
    __shared__ float Bs[16][132];
    const int tid = threadIdx.x, tx = tid & 15, ty = tid >> 4;
    const int bm = blockIdx.y * 128, bn = blockIdx.x * 128;
    float acc[8][8];
#pragma unroll
    for (int i = 0; i < 8; ++i)
#pragma unroll
        for (int j = 0; j < 8; ++j) acc[i][j] = 0.f;
    for (int k0 = 0; k0 < K; k0 += 16) {
#pragma unroll
        for (int i = 0; i < 2; ++i) {
            const int idx = tid + i * 256;
            const int r = idx >> 2, k4 = idx & 3;
            const float4 a = *(const float4*)(A + (size_t)(bm + r) * lda + k0 + k4 * 4);
            As[k4 * 4 + 0][r] = a.x; As[k4 * 4 + 1][r] = a.y; As[k4 * 4 + 2][r] = a.z; As[k4 * 4 + 3][r] = a.w;
            const int kr = idx >> 5, c4 = idx & 31;
            const float4 bv = *(const float4*)(Bw + (size_t)(k0 + kr) * ldb + bn + c4 * 4);
            *(float4*)&Bs[kr][c4 * 4] = bv;
        }
        __syncthreads();
#pragma unroll
        for (int kk = 0; kk < 16; ++kk) {
            float a[8], b[8];
#pragma unroll
            for (int i = 0; i < 8; ++i) a[i] = As[kk][ty * 8 + i];
#pragma unroll
            for (int j = 0; j < 8; ++j) b[j] = Bs[kk][tx * 8 + j];
#pragma unroll
            for (int i = 0; i < 8; ++i)
#pragma unroll
                for (int j = 0; j < 8; ++j) acc[i][j] += a[i] * b[j];
        }
        __syncthreads();
    }
#pragma unroll
    for (int i = 0; i < 8; ++i)
#pragma unroll
        for (int j = 0; j < 8; ++j) E(bm + ty * 8 + i, bn + tx * 8 + j, acc[i][j]);
}
struct EpiStore { float* C; int ldc; int pad; __device__ void operator()(int m, int n, float v) const { C[(size_t)m * ldc + n] = v; } };
struct EpiGate { float* YA; const float* YB; int pass; int pad; __device__ void operator()(int m, int n, float v) const {
    const float sg = 1.f / (1.f + expf(-v)); const size_t i = (size_t)m * D + n;
    if (pass == 0) YA[i] = sg * YA[i]; else YA[i] = YA[i] + sg * YB[i]; } };
struct EpiRes { const float* base; float* out; const float* mod; int gidx; int row0; __device__ void operator()(int m, int n, float v) const {
    const int row = row0 + m; const int b = row / S; const size_t i = (size_t)row * D + n;
    out[i] = base[i] + mod[(size_t)b * NMOD * D + gidx * D + n] * v; } };
struct EpiRelu2 { float* C; int ldc; int pad; __device__ void operator()(int m, int n, float v) const { const float r = fmaxf(v, 0.f); C[(size_t)m * ldc + n] = r * r; } };

__global__ void __launch_bounds__(64) k_kmean(const float* qkv, float* kmean) {
    const int id = blockIdx.x;
    const int blk = id & 15, h = (id >> 4) & 7, b = id >> 7, lane = threadIdx.x;
    float s = 0.f;
    for (int r = 0; r < 256; ++r) s += qkv[(size_t)(b * S + blk * 256 + r) * QKVW + OFF_KB + h * 64 + lane];
    kmean[(size_t)id * 64 + lane] = s * (1.f / 256.f);
}

__global__ void __launch_bounds__(256) k_swa(const float* qkv, const float* sinks, const float* rel_bias, float* oa) {
    __shared__ float pl[4][128];
    const int w = threadIdx.x >> 6, lane = threadIdx.x & 63;
    const int gid = blockIdx.x * 4 + w;
    const int hq = gid & 7, row = gid >> 3, t = row % S, b = row / S, hk = hq >> 2;
    const float* qp = qkv + (size_t)row * QKVW + OFF_QA + hq * 64;
    float q[64];
#pragma unroll
    for (int d4 = 0; d4 < 16; ++d4) { const float4 v = *(const float4*)(qp + d4 * 4); q[d4 * 4] = v.x; q[d4 * 4 + 1] = v.y; q[d4 * 4 + 2] = v.z; q[d4 * 4 + 3] = v.w; }
    float sc[2];
#pragma unroll
    for (int i = 0; i < 2; ++i) {
        const int dist = lane + 64 * i, kp = t - dist;
        float s = -INFINITY;
        if (kp >= 0) {
            const float* kr = qkv + (size_t)(b * S + kp) * QKVW + OFF_KA + hk * 64;
            float a = 0.f;
#pragma unroll
            for (int d4 = 0; d4 < 16; ++d4) { const float4 v = *(const float4*)(kr + d4 * 4); a += q[d4 * 4] * v.x; a += q[d4 * 4 + 1] * v.y; a += q[d4 * 4 + 2] * v.z; a += q[d4 * 4 + 3] * v.w; }
            s = a * 0.125f + rel_bias[t5_bucket(dist) * 16 + hq];
        }
        sc[i] = s;
    }
    const float sink = sinks[hq];
    const float m = fmaxf(wave_max(fmaxf(sc[0], sc[1])), sink);
    const float p0 = expf(sc[0] - m), p1 = expf(sc[1] - m);
    const float den = wave_sum(p0 + p1) + expf(sink - m);
    pl[w][lane] = p0 / den; pl[w][lane + 64] = p1 / den;
    __syncthreads();
    float o = 0.f;
    for (int dist = 0; dist < 128; ++dist) {
        const int kp = t - dist;
        if (kp >= 0) o += pl[w][dist] * qkv[(size_t)(b * S + kp) * QKVW + OFF_VA + hk * 64 + lane];
    }
    oa[(size_t)row * 512 + hq * 64 + lane] = o;
}

__global__ void __launch_bounds__(256) k_moba(const float* qkv, const float* kmean, const float* rel_bias, float* ob) {
    __shared__ float pl[4][1024];
    const int w = threadIdx.x >> 6, lane = threadIdx.x & 63;
    const int gid = blockIdx.x * 4 + w;
    const int h = gid & 7, row = gid >> 3, t = row % S, b = row / S, qblk = t >> 8;
    const float* qp = qkv + (size_t)row * QKVW + OFF_QB + h * 64;
    float q[64];
#pragma unroll
    for (int d4 = 0; d4 < 16; ++d4) { const float4 v = *(const float4*)(qp + d4 * 4); q[d4 * 4] = v.x; q[d4 * 4 + 1] = v.y; q[d4 * 4 + 2] = v.z; q[d4 * 4 + 3] = v.w; }
    float gate = -INFINITY;
    if (lane < qblk) {
        const float* km = kmean + ((size_t)(b * 8 + h) * 16 + lane) * 64;
        float a = 0.f;
#pragma unroll
        for (int d = 0; d < 64; ++d) a += q[d] * km[d];
        gate = a;
    }
    int sel[3];
    const int nsel = qblk < 3 ? qblk : 3;
#pragma unroll
    for (int r = 0; r < 3; ++r) {
        const float mx = wave_max(gate);
        const unsigned long long bal = __ballot(gate == mx && lane < 16);
        const int idx = __ffsll((long long)bal) - 1;
        sel[r] = idx;
        if (lane == idx) gate = -INFINITY;
    }
    const int seg_blk[4] = {sel[0], sel[1], sel[2], qblk};
    float sc[16];
    float mx = -INFINITY;
#pragma unroll
    for (int seg = 0; seg < 4; ++seg) {
        const bool seg_valid = (seg == 3) || (seg < nsel);
        const int blk = seg_blk[seg];
#pragma unroll
        for (int i = 0; i < 4; ++i) {
            const int kp = blk * 256 + i * 64 + lane;
            float s = -INFINITY;
            if (seg_valid && kp <= t) {
                const float* kr = qkv + (size_t)(b * S + kp) * QKVW + OFF_KB + h * 64;
                float a = 0.f;
#pragma unroll
                for (int d4 = 0; d4 < 16; ++d4) { const float4 v = *(const float4*)(kr + d4 * 4); a += q[d4 * 4] * v.x; a += q[d4 * 4 + 1] * v.y; a += q[d4 * 4 + 2] * v.z; a += q[d4 * 4 + 3] * v.w; }
                s = a * 0.125f + rel_bias[t5_bucket(t - kp) * 16 + 8 + h];
            }
            sc[seg * 4 + i] = s; mx = fmaxf(mx, s);
        }
    }
    mx = wave_max(mx);
    float sum = 0.f;
#pragma unroll
    for (int i = 0; i < 16; ++i) { sc[i] = expf(sc[i] - mx); sum += sc[i]; }
    sum = wave_sum(sum);
    const float inv = 1.f / sum;
#pragma unroll
    for (int i = 0; i < 16; ++i) pl[w][i * 64 + lane] = sc[i] * inv;
    __syncthreads();
    float o = 0.f;
#pragma unroll
    for (int seg = 0; seg < 4; ++seg) {
        const bool seg_valid = (seg == 3) || (seg < nsel);
        const int blk = seg_blk[seg];
        if (seg_valid) {
            for (int j = 0; j < 256; ++j) {
                const int kp = blk * 256 + j;
                if (kp <= t) o += pl[w][seg * 256 + j] * qkv[(size_t)(b * S + kp) * QKVW + OFF_VB + h * 64 + lane];
            }
        }
    }
    ob[(size_t)row * 512 + h * 64 + lane] = o;
}
}

extern "C" void kernel_launch(void* const* d_in, const int* in_sizes, int n_in, void* d_out, int out_size, void* d_ws, size_t ws_size, hipStream_t stream) {
    using namespace nv;
    const float* x = (const float*)d_in[0]; const float* c = (const float*)d_in[1]; const float* ada_w = (const float*)d_in[2]; const float* ada_b = (const float*)d_in[3];
    const float* n1g = (const float*)d_in[4]; const float* n2g = (const float*)d_in[5]; const float* w_in = (const float*)d_in[6]; const float* sinks = (const float*)d_in[7];
    const float* rel_bias = (const float*)d_in[8]; const float* wa = (const float*)d_in[9]; const float* wb = (const float*)d_in[10]; const float* wo = (const float*)d_in[11];
    const float* w1 = (const float*)d_in[12]; const float* w2 = (const float*)d_in[13]; const float* fg = (const float*)d_in[14];
    char* ws = (char*)d_ws; float* out = (float*)d_out;
    float* Hb = (float*)(ws + 0);
    float* QKV = (float*)(ws + 64 * MiB);
    float* mod = (float*)(ws + 208 * MiB);
    float* kmean = (float*)(ws + 208 * MiB + 128 * 1024);
    float* OA = out; float* OB = out + (size_t)M * 512;
    float* YA = (float*)(ws + 64 * MiB); float* YB = (float*)(ws + 128 * MiB);
    float* X1 = (float*)(ws + 128 * MiB);
    float* H2 = (float*)(ws + 0);
    float* ACT = (float*)(ws + 64 * MiB);

    hipLaunchKernelGGL(k_mod, dim3(NMOD * D / 256), dim3(256), 0, stream, c, ada_w, ada_b, mod);
    hipLaunchKernelGGL(k_norm, dim3(M / 4), dim3(256), 0, stream, x, n1g, (const float*)mod, 0, 1, Hb);
    hipLaunchKernelGGL(k_gemm<EpiStore>, dim3(QKVW / 128, M / 128), dim3(256), 0, stream, (const float*)Hb, D, w_in, INTOT, D, EpiStore{QKV, QKVW, 0});
    hipLaunchKernelGGL(k_kmean, dim3(B * 8 * 16), dim3(64), 0, stream, (const float*)QKV, kmean);
    hipLaunchKernelGGL(k_swa, dim3(M * 8 / 4), dim3(256), 0, stream, (const float*)QKV, sinks, rel_bias, OA);
    hipLaunchKernelGGL(k_moba, dim3(M * 8 / 4), dim3(256), 0, stream, (const float*)QKV, (const float*)kmean, rel_bias, OB);
    hipLaunchKernelGGL(k_gemm<EpiStore>, dim3(D / 128, M / 128), dim3(256), 0, stream, (const float*)OA, 512, wa, D, 512, EpiStore{YA, D, 0});
    hipLaunchKernelGGL(k_gemm<EpiStore>, dim3(D / 128, M / 128), dim3(256), 0, stream, (const float*)OB, 512, wb, D, 512, EpiStore{YB, D, 0});
    hipLaunchKernelGGL(k_gemm<EpiGate>, dim3(D / 128, M / 128), dim3(256), 0, stream, (const float*)Hb, D, w_in + OFF_GA, INTOT, D, EpiGate{YA, YB, 0, 0});
    hipLaunchKernelGGL(k_gemm<EpiGate>, dim3(D / 128, M / 128), dim3(256), 0, stream, (const float*)Hb, D, w_in + OFF_GB, INTOT, D, EpiGate{YA, YB, 1, 0});
    hipLaunchKernelGGL(k_gemm<EpiRes>, dim3(D / 128, M / 128), dim3(256), 0, stream, (const float*)YA, D, wo, D, D, EpiRes{x, X1, mod, 2, 0});
    hipLaunchKernelGGL(k_norm, dim3(M / 4), dim3(256), 0, stream, (const float*)X1, n2g, (const float*)mod, 3, 4, H2);
    for (int ch = 0; ch < 4; ++ch) {
        const int r0 = ch * 4096;
        hipLaunchKernelGGL(k_gemm<EpiRelu2>, dim3(DFF / 128, 4096 / 128), dim3(256), 0, stream, (const float*)(H2 + (size_t)r0 * D), D, w1, DFF, D, EpiRelu2{ACT, DFF, 0});
        hipLaunchKernelGGL(k_gemm<EpiRes>, dim3(D / 128, 4096 / 128), dim3(256), 0, stream, (const float*)ACT, DFF, w2, D, DFF, EpiRes{X1, out, mod, 5, r0});
    }
    hipLaunchKernelGGL(k_norm, dim3(M / 4), dim3(256), 0, stream, (const float*)out, fg, (const float*)nullptr, 0, 0, out);
}
```

```cpp
#include <hip/hip_runtime.h>
#include <cstdio>
#include <cstdint>
#include <cmath>

#ifndef MK_SIMPLE_ATTN
#define MK_SIMPLE_ATTN 1
#endif
#ifndef MK_PH_STEP
#define MK_PH_STEP 16
#endif

#ifndef MK_PROBE_DUMP
#define MK_PROBE_DUMP 0
#endif
#ifndef MK_PROBE_SRC
#define MK_PROBE_SRC WS_O
#endif

namespace pg8 {
#define PG8_LAS __attribute__((address_space(3)))
typedef unsigned short bf16_t;
typedef short bf16x8 __attribute__((ext_vector_type(8)));
typedef float f32x4 __attribute__((ext_vector_type(4)));
typedef unsigned u32x4 __attribute__((ext_vector_type(4)));
constexpr int BM = 256, BK = 64, HALF = 128, HTB = HALF * BK * 2  , STAGE_BYTES = 8 * HTB, NXCD = 8, WGM = 8;

__host__ __device__ __forceinline__ int lds_byte(int r, int c) { const int st = (r >> 4) * 2 + (c >> 5), rr = r & 15, cc = c & 31, ob = rr * 64 + cc * 2; return st * 1024 + (ob ^ (((ob >> 9) & 1) << 5)); }
__host__ __device__ __forceinline__ void stage_rc(int b, int& R, int& C) { const int st = b / 1024, sb = b % 1024, swz = sb ^ (((sb >> 9) & 1) << 5); R = (st >> 1) * 16 + swz / 64; C = (st & 1) * 32 + (swz % 64) / 2; }
__host__ __device__ __forceinline__ int perm32(int rho) { const int n = rho >> 4, i = rho & 15; return 8 * (i >> 2) + 4 * n + (i & 3); }

struct Unit { int pm, pn, koff, pass; };
struct Gemm { const bf16_t* A; const bf16_t* Bt; int K, ld; };

struct StaticOrder {
    int nM, nN, nwg, G, c;
    __host__ __device__ void init(int M, int N, int G_, int c_) { nM = M / BM; nN = N / BM; nwg = nM * nN; G = G_; c = c_; }
    __host__ __device__ bool next(int i, Unit& u) const {
        const long L = (long)i * G + c; if (L >= nwg) return false;
        int wgid = (int)L; { const int q = nwg / NXCD, r = nwg % NXCD, xcd = wgid % NXCD, off = wgid / NXCD; wgid = (xcd < r ? xcd * (q + 1) : r * (q + 1) + (xcd - r) * q) + off; }
        const int nig = WGM * nN, gid = wgid / nig, fm = gid * WGM, gsz = (nM - fm) < WGM ? (nM - fm) : WGM;
        u.pm = fm + ((wgid % nig) % gsz); u.pn = (wgid % nig) / gsz; u.koff = 0; u.pass = 0; return true;
    }
    __device__ __forceinline__ void a_ready(const Unit&) const {}
    __device__ __forceinline__ void done(const Unit&) const {}
};


typedef float f32x2_t __attribute__((ext_vector_type(2))); typedef __bf16 bf16x2_t __attribute__((ext_vector_type(2)));
__device__ __forceinline__ unsigned cvt_pk_bf16(float lo, float hi) { const f32x2_t v = {lo, hi}; const bf16x2_t b = __builtin_convertvector(v, bf16x2_t); return __builtin_bit_cast(unsigned, b); }
__device__ __forceinline__ float bf_lo(unsigned w) { return __uint_as_float(w << 16); }
__device__ __forceinline__ float bf_hi(unsigned w) { return __uint_as_float(w & 0xffff0000u); }
__device__ __forceinline__ float sigmoidf_fast(float v) { return __builtin_amdgcn_rcpf(1.0f + __builtin_amdgcn_exp2f(-1.4426950408889634f * v)); }
#ifndef MK_PROBE_TREAD
#define MK_PROBE_TREAD 1
#endif
#ifndef MK_PROBE_GMODE
#define MK_PROBE_GMODE 2
#endif
constexpr float QSCALE = 0.125f * 1.4426950408889634f;

struct EpiProj {
    static constexpr bool PERM = true, AFTER_DRAIN = false;
    bf16_t *QA, *KA, *VA, *QB, *KB, *VB, *GA, *GB; float* kmean;
    __device__ __forceinline__ void operator()(const f32x4 (&acc)[2][2][4][2], const Unit& u, int wr, int wc, int fr, int fq) const {
        const int pn = u.pn, row0 = u.pm * BM + wr * 64 + fr, cw = wc * 32 + 8 * fq;
#pragma unroll
        for (int bj = 0; bj < 2; ++bj) {
            bf16_t* dst; int ldc, colb, mode;
            if (pn < 2)       { dst = QA; ldc = 512;  colb = pn * 256 + bj * HALF; mode = 1; }
            else if (pn == 2) { dst = bj ? VA : KA; ldc = 128; colb = 0; mode = 0; }
            else if (pn < 5)  { dst = QB; ldc = 512;  colb = (pn - 3) * 256 + bj * HALF; mode = 1; }
            else if (pn < 7)  { dst = KB; ldc = 512;  colb = (pn - 5) * 256 + bj * HALF; mode = 0; }
            else if (pn < 9)  { dst = VB; ldc = 512;  colb = (pn - 7) * 256 + bj * HALF; mode = 0; }
            else if (pn < 13) { dst = GA; ldc = 1024; colb = (pn - 9) * 256 + bj * HALF; mode = MK_PROBE_GMODE; }
            else              { dst = GB; ldc = 1024; colb = (pn - 13) * 256 + bj * HALF; mode = MK_PROBE_GMODE; }
            bf16_t* base = dst + (size_t)row0 * ldc + colb + cw;
            if (mode == 2) {
#pragma unroll
                for (int ai = 0; ai < 2; ++ai)
#pragma unroll
                    for (int m = 0; m < 4; ++m) { const f32x4 v0 = acc[ai][bj][m][0], v1 = acc[ai][bj][m][1]; u32x4 w;
                        w.x = cvt_pk_bf16(sigmoidf_fast(v0[0]), sigmoidf_fast(v0[1])); w.y = cvt_pk_bf16(sigmoidf_fast(v0[2]), sigmoidf_fast(v0[3]));
                        w.z = cvt_pk_bf16(sigmoidf_fast(v1[0]), sigmoidf_fast(v1[1])); w.w = cvt_pk_bf16(sigmoidf_fast(v1[2]), sigmoidf_fast(v1[3]));
                        *(u32x4*)(base + (size_t)(ai * HALF + m * 16) * ldc) = w; }
            } else {
                const float sc = mode == 1 ? QSCALE : 1.0f;
#pragma unroll
                for (int ai = 0; ai < 2; ++ai)
#pragma unroll
                    for (int m = 0; m < 4; ++m) { const f32x4 v0 = acc[ai][bj][m][0] * sc, v1 = acc[ai][bj][m][1] * sc; u32x4 w;
                        w.x = cvt_pk_bf16(v0[0], v0[1]); w.y = cvt_pk_bf16(v0[2], v0[3]); w.z = cvt_pk_bf16(v1[0], v1[1]); w.w = cvt_pk_bf16(v1[2], v1[3]);
                        *(u32x4*)(base + (size_t)(ai * HALF + m * 16) * ldc) = w; }
            }
        }
        if (pn == 5 || pn == 6) {
            float* km = kmean + (size_t)u.pm * 512;
#pragma unroll
            for (int bj = 0; bj < 2; ++bj)
#pragma unroll
                for (int n = 0; n < 2; ++n)
#pragma unroll
                    for (int j = 0; j < 4; ++j) { float s = 0.f;
#pragma unroll
                        for (int ai = 0; ai < 2; ++ai)
#pragma unroll
                            for (int m = 0; m < 4; ++m) s += acc[ai][bj][m][n][j];
                        s += __shfl_xor(s, 1); s += __shfl_xor(s, 2); s += __shfl_xor(s, 4); s += __shfl_xor(s, 8);
                        if (fr == 0) atomicAdd(km + (pn - 5) * 256 + bj * HALF + cw + 4 * n + j, s * (1.0f / 256.0f)); }
        }
    }
};

struct EpiBranch {
    static constexpr bool PERM = true, AFTER_DRAIN = false;
    bf16_t* wsb; long offGA, offGB, offT, offMG;
    __device__ __forceinline__ void operator()(const f32x4 (&acc)[2][2][4][2], const Unit& u, int wr, int wc, int fr, int fq) const {
        const int row0 = u.pm * BM + wr * 64 + fr, col0 = u.pn * BM + wc * 32 + 8 * fq;
        const bf16_t* G = wsb + (u.pass ? offGB : offGA); const bf16_t* T = wsb + offT; bf16_t* dst = wsb + (u.pass ? offMG : offT);
#pragma unroll
        for (int ai = 0; ai < 2; ++ai)
#pragma unroll
            for (int m = 0; m < 4; ++m)
#pragma unroll
                for (int bj = 0; bj < 2; ++bj) {
                    const size_t off = (size_t)(row0 + ai * HALF + m * 16) * 1024 + col0 + bj * HALF;
                    const u32x4 g = *(const u32x4*)(G + off); const f32x4 v0 = acc[ai][bj][m][0], v1 = acc[ai][bj][m][1];
                    float o[8] = { bf_lo(g.x) * v0[0], bf_hi(g.x) * v0[1], bf_lo(g.y) * v0[2], bf_hi(g.y) * v0[3], bf_lo(g.z) * v1[0], bf_hi(g.z) * v1[1], bf_lo(g.w) * v1[2], bf_hi(g.w) * v1[3] };
                    if (u.pass && MK_PROBE_TREAD) { const u32x4 t = *(const u32x4*)(T + off);
                        o[0] += bf_lo(t.x); o[1] += bf_hi(t.x); o[2] += bf_lo(t.y); o[3] += bf_hi(t.y); o[4] += bf_lo(t.z); o[5] += bf_hi(t.z); o[6] += bf_lo(t.w); o[7] += bf_hi(t.w); }
                    u32x4 w; w.x = cvt_pk_bf16(o[0], o[1]); w.y = cvt_pk_bf16(o[2], o[3]); w.z = cvt_pk_bf16(o[4], o[5]); w.w = cvt_pk_bf16(o[6], o[7]);
                    *(u32x4*)(dst + off) = w; }
    }
};

__device__ __forceinline__ void tile_row_sumsq(const float (&ss)[2][4], float* SSrow  , int wr, int wc, int fr, int fq, PG8_LAS unsigned char* lds) {
    PG8_LAS float* P = (PG8_LAS float*)lds;
#pragma unroll
    for (int ai = 0; ai < 2; ++ai)
#pragma unroll
        for (int m = 0; m < 4; ++m) { float s = ss[ai][m]; s += __shfl_xor(s, 16); s += __shfl_xor(s, 32);
            if (fq == 0) P[(ai * HALF + wr * 64 + m * 16 + fr) * 4 + wc] = s; }
    asm volatile("s_waitcnt lgkmcnt(0)" ::: "memory"); __builtin_amdgcn_s_barrier(); asm volatile("" ::: "memory");
    const int t = threadIdx.x;
    if (t < 256) { const PG8_LAS float* p = P + t * 4; SSrow[t] = (p[0] + p[1]) + (p[2] + p[3]); }
}

struct EpiOut {
    static constexpr bool PERM = false, AFTER_DRAIN = true;
    const float* x; float* X1; bf16_t* A6; const float* mod; const float* g2; float* SS;
    __device__ __forceinline__ void fused(f32x4 (&acc)[2][2][4][2], const Unit& u, int wr, int wc, int fr, int fq, PG8_LAS unsigned char* lds, int wid, int lane) const {
        typedef unsigned u32x2v __attribute__((ext_vector_type(2)));
        const int b = u.pm >> 4, col0 = u.pn * BM + wc * 32 + 4 * fq;
        const float* mb = mod + (size_t)b * 6144;
        f32x4 g1[2][2], gm[2][2];
#pragma unroll
        for (int bj = 0; bj < 2; ++bj)
#pragma unroll
            for (int n = 0; n < 2; ++n) { const int c = col0 + bj * HALF + n * 16; g1[bj][n] = *(const f32x4*)(mb + 2 * 1024 + c);
                gm[bj][n] = *(const f32x4*)(g2 + c) * (*(const f32x4*)(mb + 4 * 1024 + c) + 1.0f); }
        float ss[2][4];
#pragma unroll
        for (int ai = 0; ai < 2; ++ai)
#pragma unroll
            for (int m = 0; m < 4; ++m) { const size_t off = (size_t)(u.pm * BM + ai * HALF + wr * 64 + m * 16 + fr) * 1024 + col0; float s = 0.f;
#pragma unroll
                for (int bj = 0; bj < 2; ++bj)
#pragma unroll
                    for (int n = 0; n < 2; ++n) { const f32x4 xv = *(const f32x4*)(x + off + bj * HALF + n * 16); const f32x4 x1 = xv + g1[bj][n] * acc[ai][bj][m][n];
                        *(f32x4*)(X1 + off + bj * HALF + n * 16) = x1; s += (x1[0] * x1[0] + x1[1] * x1[1]) + (x1[2] * x1[2] + x1[3] * x1[3]);
                        const f32x4 a = x1 * gm[bj][n]; u32x2v w; w.x = cvt_pk_bf16(a[0], a[1]); w.y = cvt_pk_bf16(a[2], a[3]); *(u32x2v*)(A6 + off + bj * HALF + n * 16) = w; }
                ss[ai][m] = s; if (m & 1) asm volatile("" ::: "memory"); }
        tile_row_sumsq(ss, SS + (size_t)u.pn * 16384 + (size_t)u.pm * BM, wr, wc, fr, fq, lds);
    }
};

struct EpiMlpIn {
    static constexpr bool PERM = true, AFTER_DRAIN = false;
    bf16_t* ACT; const float* SS; const float* bias2;
    __device__ __forceinline__ void operator()(const f32x4 (&acc)[2][2][4][2], const Unit& u, int wr, int wc, int fr, int fq) const {
        const int b = u.pm >> 4, row0 = u.pm * BM + wr * 64 + fr, col0 = u.pn * BM + wc * 32 + 8 * fq;
        f32x4 bv[2][2];
#pragma unroll
        for (int bj = 0; bj < 2; ++bj)
#pragma unroll
            for (int n = 0; n < 2; ++n) bv[bj][n] = *(const f32x4*)(bias2 + (size_t)b * 4096 + col0 + bj * HALF + 4 * n);
#pragma unroll
        for (int ai = 0; ai < 2; ++ai)
#pragma unroll
            for (int m = 0; m < 4; ++m) { const int row = row0 + ai * HALF + m * 16;
                const float sq = (SS[row] + SS[16384 + row]) + (SS[2 * 16384 + row] + SS[3 * 16384 + row]);
                const float rs = __builtin_amdgcn_rsqf(sq * (1.0f / 1024.0f) + 1e-6f);
                bf16_t* rowp = ACT + (size_t)row * 4096 + col0;
#pragma unroll
                for (int bj = 0; bj < 2; ++bj) { f32x4 v0 = acc[ai][bj][m][0] * rs + bv[bj][0], v1 = acc[ai][bj][m][1] * rs + bv[bj][1];
                    v0 = __builtin_elementwise_max(v0, (f32x4){0.f, 0.f, 0.f, 0.f}); v1 = __builtin_elementwise_max(v1, (f32x4){0.f, 0.f, 0.f, 0.f}); v0 = v0 * v0; v1 = v1 * v1;
                    u32x4 w; w.x = cvt_pk_bf16(v0[0], v0[1]); w.y = cvt_pk_bf16(v0[2], v0[3]); w.z = cvt_pk_bf16(v1[0], v1[1]); w.w = cvt_pk_bf16(v1[2], v1[3]);
                    *(u32x4*)(rowp + bj * HALF) = w; } }
    }
};

struct EpiMlpOut {
    static constexpr bool PERM = false, AFTER_DRAIN = true;
    float* X; const float* mod; float* SS2;
    __device__ __forceinline__ void fused(f32x4 (&acc)[2][2][4][2], const Unit& u, int wr, int wc, int fr, int fq, PG8_LAS unsigned char* lds, int wid, int lane) const {
        const int b = u.pm >> 4, col0 = u.pn * BM + wc * 32 + 4 * fq;
        const float* mb = mod + (size_t)b * 6144 + 5 * 1024;
        f32x4 g2v[2][2];
#pragma unroll
        for (int bj = 0; bj < 2; ++bj)
#pragma unroll
            for (int n = 0; n < 2; ++n) g2v[bj][n] = *(const f32x4*)(mb + col0 + bj * HALF + n * 16);
        float ss[2][4];
#pragma unroll
        for (int ai = 0; ai < 2; ++ai)
#pragma unroll
            for (int m = 0; m < 4; ++m) { const size_t off = (size_t)(u.pm * BM + ai * HALF + wr * 64 + m * 16 + fr) * 1024 + col0; float s = 0.f;
#pragma unroll
                for (int bj = 0; bj < 2; ++bj)
#pragma unroll
                    for (int n = 0; n < 2; ++n) { const f32x4 xv = *(const f32x4*)(X + off + bj * HALF + n * 16); const f32x4 x2 = xv + g2v[bj][n] * acc[ai][bj][m][n];
                        *(f32x4*)(X + off + bj * HALF + n * 16) = x2; s += (x2[0] * x2[0] + x2[1] * x2[1]) + (x2[2] * x2[2] + x2[3] * x2[3]); }
                ss[ai][m] = s; if (m & 1) asm volatile("" ::: "memory"); }
        tile_row_sumsq(ss, SS2 + (size_t)u.pn * 16384 + (size_t)u.pm * BM, wr, wc, fr, fq, lds);
    }
};

struct BranchOrder {
    StaticOrder S;
    __device__ __forceinline__ bool next(int i, Unit& u) const { if (i >= 2) return false; const bool ok = S.next(0, u); u.koff = 512 * i; u.pass = i; return ok; }
    __device__ __forceinline__ void a_ready(const Unit&) const {}
    __device__ __forceinline__ void done(const Unit&) const {}
};

template <class Epi, class Sched, bool ALIGN_EPI = false, bool SP2 = false>
__device__ __forceinline__ void gemm_phase(PG8_LAS unsigned char* lds, const Gemm g, const Sched& S, const Epi& E) {
    const int tid = threadIdx.x, wid = __builtin_amdgcn_readfirstlane(tid >> 6), lane = tid & 63, wr = wid >> 2, wc = wid & 3, fr = lane & 15, fq = lane >> 4;
    const int K = g.K, nt = K / BK, ld = g.ld;
    unsigned voffA[2], voffB[2];
#pragma unroll
    for (int i = 0; i < 2; ++i) { int R, C; stage_rc(tid * 16 + i * 8192, R, C); const int Rb = Epi::PERM ? ((R & ~31) + perm32(R & 31)) : R;
        voffA[i] = (unsigned)(R * ld + C) * 2u; voffB[i] = (unsigned)(Rb * ld + C) * 2u; }
    const size_t kstep = (size_t)(BK * 2);
    const size_t hstep = (size_t)HALF * ld * 2;
    const size_t tstep = 2 * hstep;
    const unsigned ldsw = (unsigned)wid * 1024u;
    const int aoff = lds_byte(wr * 64 + fr, fq * 8), boff = lds_byte(wc * 32 + fr, fq * 8);
#define PG8_SA(b, h) (((b) * 2 + (h)) * HTB)
#define PG8_SB(b, h) ((4 + (b) * 2 + (h)) * HTB)
#define PG8_STAGE(bufoff, gbase, voff) do { _Pragma("unroll") for (int _i = 0; _i < 2; ++_i) \
        __builtin_amdgcn_global_load_lds((const unsigned*)((const char*)(gbase) + (voff)[_i]), (PG8_LAS unsigned*)(lds + (bufoff) + ldsw + _i * 8192), 16, 0, 0); } while (0)
#define PG8_LDA(dst, b, h) do { _Pragma("unroll") for (int m = 0; m < 4; ++m) _Pragma("unroll") for (int k = 0; k < 2; ++k) dst[m][k] = *(const PG8_LAS bf16x8*)(lds + PG8_SA(b, h) + aoff + m * 2048 + k * 1024); } while (0)
#define PG8_LDB(dst, b, h) do { _Pragma("unroll") for (int n = 0; n < 2; ++n) _Pragma("unroll") for (int k = 0; k < 2; ++k) dst[n][k] = *(const PG8_LAS bf16x8*)(lds + PG8_SB(b, h) + boff + n * 2048 + k * 1024); } while (0)
#define PG8_MMA(ai, bj, At, Bt) do { __builtin_amdgcn_s_setprio(1); _Pragma("unroll") for (int m = 0; m < 4; ++m) _Pragma("unroll") for (int n = 0; n < 2; ++n) _Pragma("unroll") for (int k = 0; k < 2; ++k) \
        acc[ai][bj][m][n] = __builtin_amdgcn_mfma_f32_16x16x32_bf16(Bt[n][k], At[m][k], acc[ai][bj][m][n], 0, 0, 0); __builtin_amdgcn_s_setprio(0); } while (0)
#define PG8_WAIT_V(n) asm volatile("s_waitcnt vmcnt(" #n ")" ::: "memory")
#define PG8_WAIT_L(n) asm volatile("s_waitcnt lgkmcnt(" #n ")" ::: "memory")
#define PG8_BAR __builtin_amdgcn_s_barrier()
#define PG8_SCHED __builtin_amdgcn_sched_barrier(0)
    Unit cur, nxt; int ui = 0;
    if (!S.next(0, cur)) return;
    f32x4 acc[2][2][4][2];
#pragma unroll
    for (int a = 0; a < 2; ++a)
#pragma unroll
        for (int b = 0; b < 2; ++b)
#pragma unroll
            for (int m = 0; m < 4; ++m)
#pragma unroll
                for (int n = 0; n < 2; ++n) acc[a][b][m][n] = (f32x4){0.f, 0.f, 0.f, 0.f};
    bf16x8 At[4][2], B0[2][2], B1[2][2];
    const char* cA = (const char*)g.A + (size_t)cur.pm * tstep + (size_t)cur.koff * 2; const char* cB = (const char*)g.Bt + (size_t)cur.pn * tstep + (size_t)cur.koff * 2;
    S.a_ready(cur);
    if constexpr (SP2) {
        PG8_STAGE(PG8_SB(0, 0), cB, voffB); PG8_STAGE(PG8_SB(0, 1), cB + hstep, voffB); PG8_STAGE(PG8_SA(0, 0), cA, voffA); PG8_STAGE(PG8_SA(0, 1), cA + hstep, voffA);
        if (wr == 1) PG8_BAR;
        PG8_WAIT_V(2); PG8_BAR;
        PG8_STAGE(PG8_SB(1, 0), cB + kstep, voffB); PG8_STAGE(PG8_SA(1, 0), cA + kstep, voffA); PG8_STAGE(PG8_SB(1, 1), cB + hstep + kstep, voffB);
        PG8_WAIT_V(6); PG8_BAR;
    } else {
        PG8_STAGE(PG8_SB(0, 0), cB, voffB); PG8_STAGE(PG8_SA(0, 0), cA, voffA); PG8_STAGE(PG8_SB(0, 1), cB + hstep, voffB); PG8_STAGE(PG8_SA(0, 1), cA + hstep, voffA);
        if (wr == 1) PG8_BAR;
        PG8_WAIT_V(4); PG8_BAR;
        PG8_STAGE(PG8_SB(1, 0), cB + kstep, voffB); PG8_STAGE(PG8_SA(1, 0), cA + kstep, voffA); PG8_STAGE(PG8_SB(1, 1), cB + hstep + kstep, voffB);
        PG8_WAIT_V(6); PG8_BAR;
    }
    for (;;) {
        const bool has_next = S.next(ui + 1, nxt);
        const char* nA = has_next ? (const char*)g.A + (size_t)nxt.pm * tstep + (size_t)nxt.koff * 2 : cA; const char* nB = has_next ? (const char*)g.Bt + (size_t)nxt.pn * tstep + (size_t)nxt.koff * 2 : cB;
        for (int t = 0; t < nt; t += 2) {
            const bool last = (t == nt - 2);
            const char* a1 = cA + (size_t)(t + 1) * kstep;
            const char* a2 = last ? nA : cA + (size_t)(t + 2) * kstep; const char* b2 = last ? nB : cB + (size_t)(t + 2) * kstep;
            const char* a3 = a2 + kstep; const char* b3 = b2 + kstep;
            if (last && has_next) S.a_ready(nxt);
            if constexpr (SP2) {
            PG8_LDB(B0, 0, 0); PG8_LDB(B1, 0, 1); PG8_SCHED; PG8_LDA(At, 0, 0); PG8_STAGE(PG8_SA(1, 1), a1 + hstep, voffA);
            PG8_WAIT_V(8); PG8_WAIT_L(0); PG8_BAR; PG8_MMA(0, 0, At, B0); PG8_MMA(0, 1, At, B1); PG8_BAR; PG8_SCHED;
            PG8_LDA(At, 0, 1); PG8_STAGE(PG8_SB(0, 0), b2, voffB); PG8_STAGE(PG8_SB(0, 1), b2 + hstep, voffB); PG8_STAGE(PG8_SA(0, 0), a2, voffA);
            PG8_WAIT_V(8); PG8_WAIT_L(0); PG8_BAR; PG8_MMA(1, 0, At, B0); PG8_MMA(1, 1, At, B1); PG8_BAR; PG8_SCHED;
            PG8_LDB(B0, 1, 0); PG8_LDB(B1, 1, 1); PG8_SCHED; PG8_LDA(At, 1, 0); PG8_STAGE(PG8_SA(0, 1), a2 + hstep, voffA);
            PG8_WAIT_V(8); PG8_WAIT_L(0); PG8_BAR; PG8_MMA(0, 0, At, B0); PG8_MMA(0, 1, At, B1); PG8_BAR; PG8_SCHED;
            PG8_LDA(At, 1, 1); PG8_STAGE(PG8_SB(1, 0), b3, voffB); PG8_STAGE(PG8_SB(1, 1), b3 + hstep, voffB); PG8_STAGE(PG8_SA(1, 0), a3, voffA);
            PG8_WAIT_V(8); PG8_WAIT_L(0); PG8_BAR; PG8_MMA(1, 0, At, B0); PG8_MMA(1, 1, At, B1); PG8_BAR; PG8_SCHED;
            } else {
            PG8_LDB(B0, 0, 0); PG8_SCHED; PG8_LDA(At, 0, 0); PG8_STAGE(PG8_SA(1, 1), a1 + hstep, voffA);
            PG8_WAIT_L(8); PG8_BAR; PG8_WAIT_L(0); PG8_MMA(0, 0, At, B0); PG8_BAR; PG8_SCHED;
            PG8_LDB(B1, 0, 1); PG8_STAGE(PG8_SB(0, 0), b2, voffB);
            PG8_BAR; PG8_WAIT_L(0); PG8_MMA(0, 1, At, B1); PG8_BAR;
            PG8_LDA(At, 0, 1); PG8_STAGE(PG8_SA(0, 0), a2, voffA);
            PG8_BAR; PG8_WAIT_L(0); PG8_MMA(1, 0, At, B0); PG8_BAR; PG8_SCHED;
            PG8_STAGE(PG8_SB(0, 1), b2 + hstep, voffB);
            PG8_WAIT_V(6); PG8_BAR; PG8_MMA(1, 1, At, B1); PG8_BAR;
            PG8_LDB(B0, 1, 0); PG8_SCHED; PG8_LDA(At, 1, 0); PG8_STAGE(PG8_SA(0, 1), a2 + hstep, voffA);
            PG8_WAIT_L(8); PG8_BAR; PG8_WAIT_L(0); PG8_MMA(0, 0, At, B0); PG8_BAR; PG8_SCHED;
            PG8_LDB(B1, 1, 1); PG8_STAGE(PG8_SB(1, 0), b3, voffB);
            PG8_BAR; PG8_WAIT_L(0); PG8_MMA(0, 1, At, B1); PG8_BAR;
            PG8_LDA(At, 1, 1); PG8_STAGE(PG8_SA(1, 0), a3, voffA);
            PG8_BAR; PG8_WAIT_L(0); PG8_MMA(1, 0, At, B0); PG8_BAR; PG8_SCHED;
            PG8_STAGE(PG8_SB(1, 1), b3 + hstep, voffB);
            PG8_WAIT_V(6); PG8_BAR; PG8_MMA(1, 1, At, B1); PG8_BAR;
            }
        }
        if constexpr (ALIGN_EPI) { if (wr == 0) PG8_BAR; }
        if constexpr (!Epi::AFTER_DRAIN) { E(acc, cur, wr, wc, fr, fq); S.done(cur); }
        if (!has_next) break;
#pragma unroll
        for (int a = 0; a < 2; ++a)
#pragma unroll
            for (int b = 0; b < 2; ++b)
#pragma unroll
                for (int m = 0; m < 4; ++m)
#pragma unroll
                    for (int n = 0; n < 2; ++n) acc[a][b][m][n] = (f32x4){0.f, 0.f, 0.f, 0.f};
        cur = nxt; cA = nA; cB = nB; ++ui;
        if constexpr (ALIGN_EPI) { if (wr == 1) PG8_BAR; }
    }
    PG8_WAIT_V(0);
    if constexpr (!ALIGN_EPI) { if (wr == 0) PG8_BAR; }
    PG8_BAR;
    if constexpr (Epi::AFTER_DRAIN) { E.fused(acc, cur, wr, wc, fr, fq, lds, wid, lane); S.done(cur); }
#undef PG8_SA
#undef PG8_SB
#undef PG8_STAGE
#undef PG8_LDA
#undef PG8_LDB
#undef PG8_MMA
#undef PG8_WAIT_V
#undef PG8_WAIT_L
#undef PG8_BAR
#undef PG8_SCHED
}
}

#define GAS __attribute__((address_space(1)))
#define LAS __attribute__((address_space(3)))
typedef unsigned short bf16;
typedef unsigned v4u __attribute__((ext_vector_type(4)));
typedef float f32x4 __attribute__((ext_vector_type(4)));
typedef short bf16x8 __attribute__((ext_vector_type(8)));
typedef GAS unsigned gu32;
typedef GAS unsigned long long gu64;
#define RLX_AGENT __ATOMIC_RELAXED, __HIP_MEMORY_SCOPE_AGENT
#define LDS_WAIT() asm volatile("s_waitcnt lgkmcnt(0)" ::: "memory")
#define VM_WAIT() asm volatile("s_waitcnt vmcnt(0)" ::: "memory")
__device__ __forceinline__ unsigned long long rt() { return __builtin_amdgcn_s_memrealtime(); }
__device__ __forceinline__ unsigned f2bf(float f) { unsigned u = __builtin_bit_cast(unsigned, f); return (u + 0x7fffu + ((u >> 16) & 1u)) >> 16; }
__device__ __forceinline__ unsigned pk2(float lo, float hi) { return f2bf(lo) | (f2bf(hi) << 16); }

#define XB_TMO      128
#define XB_XCNT(j)  (256  + 64 * (j))
#define XB_XSUB(j)  (1280 + 64 * (j))
#define XB_XGEN(j)  (2304 + 64 * (j))
#define XB_TOP      3328
#define XB_TOPGEN   3392
#define XCD_BAR_WORDS 3456
#define XB_SPIN_CAP (1u << 18)

__device__ __forceinline__ unsigned xb_ld(unsigned* p)              { return __hip_atomic_load(p, __ATOMIC_RELAXED, __HIP_MEMORY_SCOPE_AGENT); }
__device__ __forceinline__ unsigned xb_add(unsigned* p, unsigned v) { return __hip_atomic_fetch_add(p, v, __ATOMIC_RELAXED, __HIP_MEMORY_SCOPE_AGENT); }
__device__ __forceinline__ unsigned xb_xcc_id() { return (unsigned)__builtin_amdgcn_s_getreg((3 << 11) | 20) & 0xFu; }
#define XB_SPIN(cond, bar) do { unsigned _sp = 0; while (cond) { __builtin_amdgcn_s_sleep(1); \
    if ((++_sp & 255u) == 0u) { if (xb_ld(&(bar)[XB_TMO])) break; if (_sp > XB_SPIN_CAP) { atomicAdd(&(bar)[XB_TMO], 1u); break; } } } } while (0)

struct XcdBarrier {
    unsigned* bar; unsigned x;
    volatile LAS unsigned* st;
};

__device__ __forceinline__ XcdBarrier xcd_barrier_post(unsigned* bar, volatile LAS unsigned* st) {
    XcdBarrier b; b.bar = bar; b.x = xb_xcc_id(); b.st = st;
    if (threadIdx.x == 0) (void)xb_add(&bar[XB_XCNT(b.x)], 1u);
    return b;
}
__device__ __forceinline__ void xcd_barrier_complete(unsigned* bar, unsigned x, unsigned& nloc, unsigned& nx) {
    const unsigned G = gridDim.x * gridDim.y * gridDim.z;
    unsigned sum, cnt, mine, sp = 0u;
    for (;;) {
        sum = 0u; cnt = 0u; mine = 0u;
#pragma unroll
        for (unsigned j = 0; j < 16; ++j) { const unsigned c = xb_ld(&bar[XB_XCNT(j)]); sum += c; cnt += (c > 0u) ? 1u : 0u; mine = (j == x) ? c : mine; }
        if (sum == G) break;
        __builtin_amdgcn_s_sleep(1);
        if ((++sp & 255u) == 0u) { if (xb_ld(&bar[XB_TMO])) break; if (sp > XB_SPIN_CAP) { atomicAdd(&bar[XB_TMO], 1u); break; } }
    }
    nloc = mine > 0u ? mine : 1u; nx = cnt > 0u ? cnt : 1u;
}

__device__ __forceinline__ void xcd_barrier(const XcdBarrier& b) {
    asm volatile("s_waitcnt vmcnt(0)" ::: "memory");
    __syncthreads();
    if (threadIdx.x == 0) {
        unsigned* bar = b.bar;
        __builtin_amdgcn_s_waitcnt(0);
        unsigned nloc = b.st[0], nx = b.st[1];
        if (nloc == 0u) { xcd_barrier_complete(bar, b.x, nloc, nx); b.st[0] = nloc; b.st[1] = nx; }
        const unsigned old = xb_add(&bar[XB_XSUB(b.x)], 1u);
        const unsigned gen = old / nloc;
        if (old + 1u == (gen + 1u) * nloc) {
            __builtin_amdgcn_fence(__ATOMIC_RELEASE, "agent");
            asm volatile("s_waitcnt vmcnt(0)" ::: "memory");
            const unsigned og = xb_add(&bar[XB_TOP], 1u);
            const unsigned tg = og / nx;
            if (og + 1u == (tg + 1u) * nx) xb_add(&bar[XB_TOPGEN], 1u);
            else XB_SPIN(xb_ld(&bar[XB_TOPGEN]) == tg, bar);
            __builtin_amdgcn_fence(__ATOMIC_ACQUIRE, "agent");
            xb_add(&bar[XB_XGEN(b.x)], 1u);
            asm volatile("s_waitcnt vmcnt(0)" ::: "memory");
        } else {
            XB_SPIN(xb_ld(&bar[XB_XGEN(b.x)]) == gen, bar);
            __builtin_amdgcn_fence(__ATOMIC_ACQUIRE, "agent");
            asm volatile("s_waitcnt vmcnt(0)" ::: "memory");
        }
    }
    __syncthreads();
}

constexpr int NWAVES = 8;
constexpr int BATCH = 4, SEQ = 4096, D = 1024, M = BATCH * SEQ, FF = 4096, INTOT = 4352, NMOD = 6;
constexpr float RMS_EPS = 1e-6f;
constexpr float LOG2E = 1.4426950408889634f;
constexpr size_t MiB = 1u << 20;
constexpr size_t WS_CTL = 0, CTL_ZERO_BYTES = 1 * MiB;
constexpr size_t WS_KMEAN = 256 * 1024;
constexpr size_t WS_MOD = 1 * MiB;
constexpr size_t WS_BIAS2 = 1 * MiB + 128 * 1024;
constexpr size_t WS_SS = 1 * MiB + 256 * 1024;
constexpr size_t WS_SS2 = 1 * MiB + 512 * 1024;
constexpr size_t WS_WIN = 2 * MiB, WS_WAB = 11 * MiB, WS_WO = 13 * MiB, WS_W1 = 15 * MiB, WS_W2 = 23 * MiB;
constexpr size_t WS_HA = 32 * MiB;
constexpr size_t WS_QA = 64 * MiB, WS_QB = 80 * MiB, WS_KB = 96 * MiB, WS_VB = 112 * MiB, WS_KA = 128 * MiB, WS_VA = 132 * MiB, WS_GA = 136 * MiB, WS_GB = 168 * MiB;
constexpr size_t WS_O = 200 * MiB;
constexpr size_t WS_MG = 64 * MiB;
constexpr size_t WS_ACT = 64 * MiB;
constexpr size_t WS_MODP = 232 * MiB;
constexpr size_t WS_END = 256 * MiB;
constexpr int CW_TMO = 0, CW_CODE = 1, CW_BAR = 4096;
constexpr int RING_OFF = 0, RING_BYTES = 131072;
constexpr int LDSCTL_OFF = RING_BYTES, MISC_OFF = LDSCTL_OFF + 320, VEC_OFF = RING_BYTES + 1024;
constexpr int LDS_BYTES = 147456;

struct Frame {
    LAS unsigned char* lds;
    volatile LAS unsigned* MISC;
    gu32* ctl;
    int tid, lane, wave, G;
};
__device__ __forceinline__ float wave_sum(float v) {
#pragma unroll
    for (int o = 1; o < 64; o <<= 1) v += __shfl_xor(v, o);
    return v;
}
__device__ __forceinline__ void transpose_item(const float* W, int N, bf16* WT, int ldt, int koff, LAS float* scr, int item, int lane) {
    const int nblk = N / 32, kb = item / nblk, nb = item % nblk, k0 = 64 * kb, n0 = 32 * nb;
#pragma unroll 8
    for (int i = 0; i < 32; ++i) { const int kk = 2 * i + (lane >> 5); scr[kk * 33 + (lane & 31)] = W[(size_t)(k0 + kk) * N + n0 + (lane & 31)]; }
    LDS_WAIT(); asm volatile("" ::: "memory");
    const int c = lane & 7;
#pragma unroll
    for (int j = 0; j < 4; ++j) { const int n = (lane >> 3) + 8 * j; const LAS float* s = scr + (8 * c) * 33 + n;
        v4u o; o.x = pk2(s[0 * 33], s[1 * 33]); o.y = pk2(s[2 * 33], s[3 * 33]); o.z = pk2(s[4 * 33], s[5 * 33]); o.w = pk2(s[6 * 33], s[7 * 33]);
        *(GAS v4u*)(WT + (size_t)(n0 + n) * ldt + koff + k0 + 8 * c) = o; }
    LDS_WAIT(); asm volatile("" ::: "memory");
}

struct Ptrs {
    const float *x, *c, *ada_w, *ada_b, *n1g, *n2g, *w_in, *sinks, *rel_bias, *wa, *wb, *wo, *w1, *w2, *fg;
    float* out; unsigned char* ws;
};

__device__ __forceinline__ void p0_mod_partial(Frame& F, const Ptrs& P) {
    LAS float* sl = (LAS float*)(F.lds + RING_OFF);
    LAS float* red = (LAS float*)(F.lds + RING_OFF + 4096);
    const int j = blockIdx.x, cb = j & 15, ks = j >> 4;
    if (F.tid < 256) { const int b = F.tid >> 6, k = F.tid & 63; const float cv = P.c[b * D + ks * 64 + k]; sl[F.tid] = cv / (1.0f + __expf(-cv)); }
    __syncthreads();
    float acc[4][6];
#pragma unroll
    for (int b = 0; b < 4; ++b)
#pragma unroll
        for (int q = 0; q < 6; ++q) acc[b][q] = 0.f;
    const float* wbase = P.ada_w + (size_t)(ks * 64 + F.wave * 8) * (NMOD * D) + cb * 384 + F.lane;
#pragma unroll
    for (int r = 0; r < 8; ++r) { float wv[6];
#pragma unroll
        for (int q = 0; q < 6; ++q) wv[q] = wbase[(size_t)r * (NMOD * D) + 64 * q];
#pragma unroll
        for (int b = 0; b < 4; ++b) { const float s = sl[b * 64 + F.wave * 8 + r];
#pragma unroll
            for (int q = 0; q < 6; ++q) acc[b][q] += s * wv[q]; } }
#pragma unroll
    for (int b = 0; b < 4; ++b)
#pragma unroll
        for (int q = 0; q < 6; ++q) red[(F.wave * 4 + b) * 384 + 64 * q + F.lane] = acc[b][q];
    __syncthreads();
    float* modp = (float*)(P.ws + WS_MODP);
    for (int idx = F.tid; idx < 4 * 384; idx += NWAVES * 64) { const int b = idx / 384, cc = idx % 384; float s = 0.f;
#pragma unroll
        for (int w = 0; w < 8; ++w) s += red[(w * 4 + b) * 384 + cc];
        modp[((size_t)ks * 4 + b) * (NMOD * D) + cb * 384 + cc] = s; }
    __syncthreads();
}
__device__ __forceinline__ float mod_from_partials(const float* modp, const float* ada_b, int b, int n) {
    float s = ada_b[n];
#pragma unroll
    for (int ks = 0; ks < 16; ++ks) s += modp[((size_t)ks * 4 + b) * (NMOD * D) + n];
    return s;
}
__device__ __forceinline__ void p1_prologue(Frame& F, const Ptrs& P) {
    const float* modp = (const float*)(P.ws + WS_MODP);
    float* mod = (float*)(P.ws + WS_MOD);
    const int j = blockIdx.x;
    if (F.tid < 96) { const int i = j * 96 + F.tid; mod[i] = mod_from_partials(modp, P.ada_b, i / (NMOD * D), i % (NMOD * D)); }
    if (F.tid < 128) ((float*)(P.ws + WS_KMEAN))[j * 128 + F.tid] = 0.f;
    LAS float* gm1 = (LAS float*)(F.lds + VEC_OFF); LAS float* sh1 = gm1 + D;
    { const int b = j >> 6;
      for (int d = F.tid; d < D; d += NWAVES * 64) { gm1[d] = P.n1g[d] * (1.0f + mod_from_partials(modp, P.ada_b, b, D + d)); sh1[d] = mod_from_partials(modp, P.ada_b, b, d); } }
    LAS float* scr = (LAS float*)(F.lds + RING_OFF + F.wave * 16384);
    const int gw = j * NWAVES + F.wave, NGW = F.G * NWAVES;
    constexpr int I_IN = (D / 64) * (INTOT / 32), I_A = (512 / 64) * (D / 32), I_O = (D / 64) * (D / 32), I_1 = (D / 64) * (FF / 32), I_2 = (FF / 64) * (D / 32);
    constexpr int NITEMS = I_IN + 2 * I_A + I_O + I_1 + I_2;
    bf16* WIN = (bf16*)(P.ws + WS_WIN); bf16* WAB = (bf16*)(P.ws + WS_WAB); bf16* WO = (bf16*)(P.ws + WS_WO); bf16* W1 = (bf16*)(P.ws + WS_W1); bf16* W2 = (bf16*)(P.ws + WS_W2);
    for (int it = gw; it < NITEMS; it += NGW) {
        int r = it;
        if (r < I_IN) { transpose_item(P.w_in, INTOT, WIN, D, 0, scr, r, F.lane); continue; } r -= I_IN;
        if (r < I_A) { transpose_item(P.wa, D, WAB, D, 0, scr, r, F.lane); continue; } r -= I_A;
        if (r < I_A) { transpose_item(P.wb, D, WAB, D, 512, scr, r, F.lane); continue; } r -= I_A;
        if (r < I_O) { transpose_item(P.wo, D, WO, D, 0, scr, r, F.lane); continue; } r -= I_O;
        if (r < I_1) { transpose_item(P.w1, FF, W1, D, 0, scr, r, F.lane); continue; } r -= I_1;
        transpose_item(P.w2, D, W2, FF, 0, scr, r, F.lane);
    }
    __syncthreads();
    bf16* HA = (bf16*)(P.ws + WS_HA);
    for (int r = 0; r < 8; ++r) {
        const int row = j * 64 + F.wave * 8 + r;
        const GAS f32x4* xr = (const GAS f32x4*)(P.x + (size_t)row * D) + F.lane;
        f32x4 v[4]; float s = 0.f;
#pragma unroll
        for (int q = 0; q < 4; ++q) { v[q] = xr[64 * q]; s += (v[q].x * v[q].x + v[q].y * v[q].y) + (v[q].z * v[q].z + v[q].w * v[q].w); }
        const float rstd = 1.0f / sqrtf(wave_sum(s) * (1.0f / D) + RMS_EPS);
        GAS unsigned long long* o8 = (GAS unsigned long long*)(HA + (size_t)row * D) + F.lane;
#pragma unroll
        for (int q = 0; q < 4; ++q) { const int c0 = 4 * F.lane + 256 * q;
            const f32x4 g = *(const LAS f32x4*)(gm1 + c0), sh = *(const LAS f32x4*)(sh1 + c0); const f32x4 h = v[q] * rstd * g + sh;
            o8[64 * q] = (unsigned long long)pk2(h.x, h.y) | ((unsigned long long)pk2(h.z, h.w) << 32); }
    }
}
__device__ __forceinline__ void p2_bias2(Frame& F, const Ptrs& P) {
    LAS float* sh2 = (LAS float*)(F.lds + RING_OFF);
    const float* mod = (const float*)(P.ws + WS_MOD);
    for (int i = F.tid; i < 4 * D; i += NWAVES * 64) sh2[i] = mod[(size_t)(i >> 10) * (NMOD * D) + 3 * D + (i & 1023)];
    __syncthreads();
    const bf16* W1 = (const bf16*)(P.ws + WS_W1); float* bias2 = (float*)(P.ws + WS_BIAS2);
#pragma unroll
    for (int q = 0; q < 2; ++q) {
        const int n = blockIdx.x * 16 + F.wave * 2 + q;
        const v4u w0 = *(const GAS v4u*)(W1 + (size_t)n * D + F.lane * 16), w1v = *(const GAS v4u*)(W1 + (size_t)n * D + F.lane * 16 + 8);
        float wv[16] = { __uint_as_float(w0.x << 16), __uint_as_float(w0.x & 0xffff0000u), __uint_as_float(w0.y << 16), __uint_as_float(w0.y & 0xffff0000u), __uint_as_float(w0.z << 16), __uint_as_float(w0.z & 0xffff0000u), __uint_as_float(w0.w << 16), __uint_as_float(w0.w & 0xffff0000u),
                         __uint_as_float(w1v.x << 16), __uint_as_float(w1v.x & 0xffff0000u), __uint_as_float(w1v.y << 16), __uint_as_float(w1v.y & 0xffff0000u), __uint_as_float(w1v.z << 16), __uint_as_float(w1v.z & 0xffff0000u), __uint_as_float(w1v.w << 16), __uint_as_float(w1v.w & 0xffff0000u) };
#pragma unroll
        for (int b = 0; b < 4; ++b) { float s = 0.f;
#pragma unroll
            for (int e = 0; e < 16; ++e) s += wv[e] * sh2[b * D + F.lane * 16 + e];
            s = wave_sum(s); if (F.lane == 0) bias2[b * FF + n] = s; }
    }
    __syncthreads();
}
__device__ __forceinline__ void p8_final_norm(Frame& F, const Ptrs& P) {
    const float* SS2 = (const float*)(P.ws + WS_SS2);
    const int gw = blockIdx.x * NWAVES + F.wave, NGW = F.G * NWAVES;
    f32x4 g[4];
#pragma unroll
    for (int q = 0; q < 4; ++q) g[q] = *(const GAS f32x4*)(P.fg + 4 * F.lane + 256 * q);
    for (int row = gw; row < M; row += NGW) {
        const float sq = (SS2[row] + SS2[16384 + row]) + (SS2[2 * 16384 + row] + SS2[3 * 16384 + row]);
        const float rstd = 1.0f / sqrtf(sq * (1.0f / D) + RMS_EPS);
        GAS f32x4* xr = (GAS f32x4*)(P.out + (size_t)row * D) + F.lane;
#pragma unroll
        for (int q = 0; q < 4; ++q) { const f32x4 v = xr[64 * q]; xr[64 * q] = v * rstd * g[q]; }
    }
}

namespace sa {
__device__ __forceinline__ int t5_bucket(int d) {
    if (d < 16) return d;
    int b = 16;
    b += (d >= 22); b += (d >= 30); b += (d >= 40); b += (d >= 54); b += (d >= 73); b += (d >= 99); b += (d >= 134); b += (d >= 182);
    b += (d >= 246); b += (d >= 332); b += (d >= 450); b += (d >= 609); b += (d >= 825); b += (d >= 1117); b += (d >= 1513);
    return b;
}
__device__ __forceinline__ float wave_max(float v) {
#pragma unroll
    for (int o = 1; o < 64; o <<= 1) v = fmaxf(v, __shfl_xor(v, o));
    return v;
}
__device__ __forceinline__ float bf2f(bf16 v) { return __uint_as_float((unsigned)v << 16); }
__device__ __forceinline__ void load64(const bf16* p, float (&q)[64]) {
#pragma unroll
    for (int i = 0; i < 8; ++i) { const v4u w = *(const v4u*)(p + 8 * i);
        q[8 * i] = __uint_as_float(w.x << 16); q[8 * i + 1] = __uint_as_float(w.x & 0xffff0000u); q[8 * i + 2] = __uint_as_float(w.y << 16); q[8 * i + 3] = __uint_as_float(w.y & 0xffff0000u);
        q[8 * i + 4] = __uint_as_float(w.z << 16); q[8 * i + 5] = __uint_as_float(w.z & 0xffff0000u); q[8 * i + 6] = __uint_as_float(w.w << 16); q[8 * i + 7] = __uint_as_float(w.w & 0xffff0000u); }
}
__device__ __forceinline__ float dot64(const bf16* p, const float (&q)[64]) {
    float a = 0.f;
#pragma unroll
    for (int i = 0; i < 8; ++i) { const v4u w = *(const v4u*)(p + 8 * i);
        a += q[8 * i] * __uint_as_float(w.x << 16); a += q[8 * i + 1] * __uint_as_float(w.x & 0xffff0000u); a += q[8 * i + 2] * __uint_as_float(w.y << 16); a += q[8 * i + 3] * __uint_as_float(w.y & 0xffff0000u);
        a += q[8 * i + 4] * __uint_as_float(w.z << 16); a += q[8 * i + 5] * __uint_as_float(w.z & 0xffff0000u); a += q[8 * i + 6] * __uint_as_float(w.w << 16); a += q[8 * i + 7] * __uint_as_float(w.w & 0xffff0000u); }
    return a;
}
__global__ void __launch_bounds__(256) k_swa(const bf16* QA, const bf16* KA, const bf16* VA, const float* sinks, const float* rel_bias, bf16* O) {
    __shared__ float pl[4][128];
    const int w = threadIdx.x >> 6, lane = threadIdx.x & 63;
    const int gid = blockIdx.x * 4 + w, hq = gid & 7, row = gid >> 3, t = row % SEQ, b = row / SEQ, hk = hq >> 2;
    float q[64]; load64(QA + (size_t)row * 512 + hq * 64, q);
    float sc[2];
#pragma unroll
    for (int i = 0; i < 2; ++i) { const int dist = lane + 64 * i, kp = t - dist; float s = -INFINITY;
        if (kp >= 0) s = dot64(KA + (size_t)(b * SEQ + kp) * 128 + hk * 64, q) + LOG2E * rel_bias[t5_bucket(dist) * 16 + hq];
        sc[i] = s; }
    const float sink = LOG2E * sinks[hq];
    const float m = fmaxf(wave_max(fmaxf(sc[0], sc[1])), sink);
    const float p0 = exp2f(sc[0] - m), p1 = exp2f(sc[1] - m);
    const float den = wave_sum(p0 + p1) + exp2f(sink - m);
    pl[w][lane] = p0 / den; pl[w][lane + 64] = p1 / den;
    __syncthreads();
    float o = 0.f;
    for (int dist = 0; dist < 128; ++dist) { const int kp = t - dist; if (kp >= 0) o += pl[w][dist] * bf2f(VA[(size_t)(b * SEQ + kp) * 128 + hk * 64 + lane]); }
    O[(size_t)row * 1024 + hq * 64 + lane] = (bf16)f2bf(o);
}
__global__ void __launch_bounds__(256) k_moba(const bf16* QB, const bf16* KB, const bf16* VB, const float* kmean, const float* rel_bias, bf16* O) {
    __shared__ float pl[4][1024];
    const int w = threadIdx.x >> 6, lane = threadIdx.x & 63;
    const int gid = blockIdx.x * 4 + w, h = gid & 7, row = gid >> 3, t = row % SEQ, b = row / SEQ, qblk = t >> 8;
    float q[64]; load64(QB + (size_t)row * 512 + h * 64, q);
    float gate = -INFINITY;
    if (lane < qblk) { const float* km = kmean + ((size_t)(b * 16 + lane) * 8 + h) * 64; float a = 0.f;
#pragma unroll
        for (int d = 0; d < 64; ++d) a += q[d] * km[d];
        gate = a; }
    int sel[3]; const int nsel = qblk < 3 ? qblk : 3;
#pragma unroll
    for (int r = 0; r < 3; ++r) { const float mx = wave_max(gate); const unsigned long long bal = __ballot(gate == mx && lane < 16); const int idx = __ffsll((long long)bal) - 1; sel[r] = idx; if (lane == idx) gate = -INFINITY; }
    const int seg_blk[4] = {sel[0], sel[1], sel[2], qblk};
    float sc[16]; float mx = -INFINITY;
#pragma unroll
    for (int seg = 0; seg < 4; ++seg) { const bool seg_valid = (seg == 3) || (seg < nsel); const int blk = seg_blk[seg];
#pragma unroll
        for (int i = 0; i < 4; ++i) { const int kp = blk * 256 + i * 64 + lane; float s = -INFINITY;
            if (seg_valid && kp <= t) s = dot64(KB + (size_t)(b * SEQ + kp) * 512 + h * 64, q) + LOG2E * rel_bias[t5_bucket(t - kp) * 16 + 8 + h];
            sc[seg * 4 + i] = s; mx = fmaxf(mx, s); } }
    mx = wave_max(mx);
    float sum = 0.f;
#pragma unroll
    for (int i = 0; i < 16; ++i) { sc[i] = exp2f(sc[i] - mx); sum += sc[i]; }
    sum = wave_sum(sum); const float inv = 1.f / sum;
#pragma unroll
    for (int i = 0; i < 16; ++i) pl[w][i * 64 + lane] = sc[i] * inv;
    __syncthreads();
    float o = 0.f;
#pragma unroll
    for (int seg = 0; seg < 4; ++seg) { const bool seg_valid = (seg == 3) || (seg < nsel); const int blk = seg_blk[seg];
        if (seg_valid) for (int jj = 0; jj < 256; ++jj) { const int kp = blk * 256 + jj; if (kp <= t) o += pl[w][seg * 256 + jj] * bf2f(VB[(size_t)(b * SEQ + kp) * 512 + h * 64 + lane]); } }
    O[(size_t)row * 1024 + 512 + h * 64 + lane] = (bf16)f2bf(o);
}
}

struct Args { Ptrs p; int ph_lo, ph_hi, li, pad; };
__global__ void __launch_bounds__(NWAVES * 64, 2) mk_fwd(Args args) {
    extern __shared__ __attribute__((aligned(16))) unsigned char lds[];
    Frame F;
    F.lds = (LAS unsigned char*)lds;
    F.MISC = (volatile LAS unsigned*)(F.lds + MISC_OFF);
    F.tid = threadIdx.x; F.lane = F.tid & 63; F.wave = __builtin_amdgcn_readfirstlane(F.tid >> 6);
    F.G = gridDim.x;
    const Ptrs& P = args.p;
    unsigned char* ws = P.ws;
    F.ctl = (gu32*)(ws + WS_CTL);
    for (int u = F.tid; u < 1024 / 4; u += NWAVES * 64) ((LAS unsigned*)(F.lds + LDSCTL_OFF))[u] = 0u;
    __syncthreads();
    XcdBarrier bar = xcd_barrier_post((unsigned*)(F.ctl + CW_BAR) + args.li * XCD_BAR_WORDS, F.MISC + 8);
    const int lo = args.ph_lo, hi = args.ph_hi;
#define IN(k) (lo <= (k) && (k) < hi)
#define BOTH(k) (IN(k) && IN((k) + 1))
    bf16* HA = (bf16*)(ws + WS_HA); bf16* Ob = (bf16*)(ws + WS_O); bf16* MG = (bf16*)(ws + WS_MG); bf16* ACT = (bf16*)(ws + WS_ACT);
    float* mod = (float*)(ws + WS_MOD); float* SS = (float*)(ws + WS_SS); float* SS2 = (float*)(ws + WS_SS2);

    if (IN(0)) { p0_mod_partial(F, P); if (BOTH(0)) xcd_barrier(bar); }
    if (IN(1)) { p1_prologue(F, P); if (BOTH(1)) xcd_barrier(bar); }
    if (IN(2)) {
        p2_bias2(F, P);
        pg8::Gemm g{HA, (const bf16*)(ws + WS_WIN), D, D}; pg8::StaticOrder S; S.init(M, INTOT, F.G, (int)blockIdx.x);
        pg8::EpiProj E{(bf16*)(ws + WS_QA), (bf16*)(ws + WS_KA), (bf16*)(ws + WS_VA), (bf16*)(ws + WS_QB), (bf16*)(ws + WS_KB), (bf16*)(ws + WS_VB), (bf16*)(ws + WS_GA), (bf16*)(ws + WS_GB), (float*)(ws + WS_KMEAN)};
        pg8::gemm_phase<pg8::EpiProj, pg8::StaticOrder, true, true>(F.lds + RING_OFF, g, S, E);
        if (BOTH(2)) xcd_barrier(bar);
    }
    if (IN(3)) {
        if (BOTH(3)) xcd_barrier(bar);
    }
    if (IN(4)) {
        pg8::Gemm g{Ob, (const bf16*)(ws + WS_WAB), 512, D}; pg8::BranchOrder S; S.S.init(M, D, F.G, (int)blockIdx.x);
        pg8::EpiBranch E{(bf16*)ws, (long)(WS_GA / 2), (long)(WS_GB / 2), (long)(WS_HA / 2), (long)(WS_MG / 2)};
        pg8::gemm_phase<pg8::EpiBranch, pg8::BranchOrder, true, true>(F.lds + RING_OFF, g, S, E);
        if (BOTH(4)) xcd_barrier(bar);
    }
    if (IN(5)) {
        pg8::Gemm g{MG, (const bf16*)(ws + WS_WO), D, D}; pg8::StaticOrder S; S.init(M, D, F.G, (int)blockIdx.x);
        pg8::EpiOut E{P.x, P.out, HA, mod, P.n2g, SS};
        pg8::gemm_phase<pg8::EpiOut, pg8::StaticOrder, false, true>(F.lds + RING_OFF, g, S, E);
        if (BOTH(5)) xcd_barrier(bar);
    }
    if (IN(6)) {
        pg8::Gemm g{HA, (const bf16*)(ws + WS_W1), D, D}; pg8::StaticOrder S; S.init(M, FF, F.G, (int)blockIdx.x);
        pg8::EpiMlpIn E{ACT, SS, (const float*)(ws + WS_BIAS2)};
        pg8::gemm_phase<pg8::EpiMlpIn, pg8::StaticOrder, true, true>(F.lds + RING_OFF, g, S, E);
        if (BOTH(6)) xcd_barrier(bar);
    }
    if (IN(7)) {
        pg8::Gemm g{ACT, (const bf16*)(ws + WS_W2), FF, FF}; pg8::StaticOrder S; S.init(M, D, F.G, (int)blockIdx.x);
        pg8::EpiMlpOut E{P.out, mod, SS2};
        pg8::gemm_phase<pg8::EpiMlpOut, pg8::StaticOrder, false, true>(F.lds + RING_OFF, g, S, E);
        if (BOTH(7)) xcd_barrier(bar);
    }
    if (IN(8)) { p8_final_norm(F, P); }
#undef IN
#undef BOTH
}

__global__ void k_dump(const bf16* src, float* out) { const size_t i = (size_t)blockIdx.x * 256 + threadIdx.x; out[i] = __uint_as_float((unsigned)src[i] << 16); }
extern "C" void kernel_launch(void* const* d_in, const int* in_sizes, int n_in, void* d_out, int out_size, void* d_ws, size_t ws_size, hipStream_t stream) {
    static int grid = 0;
    if (grid == 0) {
        if (n_in != 15 || in_sizes[0] != M * D || out_size != M * D || ws_size < WS_END) { fprintf(stderr, "kernel_launch: unexpected shapes (n_in %d, in0 %d, out %d, ws %zu)\n", n_in, n_in > 0 ? in_sizes[0] : -1, out_size, ws_size); grid = -1; return; }
        int dev = 0, cus = 0, per_cu = 0;
        if (hipGetDevice(&dev) != hipSuccess || hipDeviceGetAttribute(&cus, hipDeviceAttributeMultiprocessorCount, dev) != hipSuccess) { grid = -1; return; }
        if (hipFuncSetAttribute((const void*)mk_fwd, hipFuncAttributeMaxDynamicSharedMemorySize, LDS_BYTES) != hipSuccess) { fprintf(stderr, "kernel_launch: hipFuncSetAttribute failed\n"); grid = -1; return; }
        if (hipOccupancyMaxActiveBlocksPerMultiprocessor(&per_cu, (const void*)mk_fwd, NWAVES * 64, LDS_BYTES) != hipSuccess || per_cu < 1) fprintf(stderr, "kernel_launch: occupancy query reports %d\n", per_cu);
        (void)hipGetLastError();
        grid = cus;
        if (grid != 256) { fprintf(stderr, "kernel_launch: built for 256 CUs, device has %d\n", cus); grid = -1; return; }
    }
    if (grid < 0) return;
    (void)hipMemsetAsync((char*)d_ws + WS_CTL, 0, CTL_ZERO_BYTES, stream);
    Args a{};
    a.p.x = (const float*)d_in[0]; a.p.c = (const float*)d_in[1]; a.p.ada_w = (const float*)d_in[2]; a.p.ada_b = (const float*)d_in[3]; a.p.n1g = (const float*)d_in[4]; a.p.n2g = (const float*)d_in[5];
    a.p.w_in = (const float*)d_in[6]; a.p.sinks = (const float*)d_in[7]; a.p.rel_bias = (const float*)d_in[8]; a.p.wa = (const float*)d_in[9]; a.p.wb = (const float*)d_in[10]; a.p.wo = (const float*)d_in[11];
    a.p.w1 = (const float*)d_in[12]; a.p.w2 = (const float*)d_in[13]; a.p.fg = (const float*)d_in[14]; a.p.out = (float*)d_out; a.p.ws = (unsigned char*)d_ws;
    unsigned char* ws = (unsigned char*)d_ws;
#if MK_SIMPLE_ATTN
    a.li = 0; a.pad = 0;
    for (int ph = 0; ph < 3; ph += MK_PH_STEP) { a.ph_lo = ph; a.ph_hi = (ph + MK_PH_STEP < 3) ? ph + MK_PH_STEP : 3; hipLaunchKernelGGL(mk_fwd, dim3(grid), dim3(NWAVES * 64), LDS_BYTES, stream, a); a.li++; }
    hipLaunchKernelGGL(sa::k_swa, dim3(M * 8 / 4), dim3(256), 0, stream, (const bf16*)(ws + WS_QA), (const bf16*)(ws + WS_KA), (const bf16*)(ws + WS_VA), a.p.sinks, a.p.rel_bias, (bf16*)(ws + WS_O));
    hipLaunchKernelGGL(sa::k_moba, dim3(M * 8 / 4), dim3(256), 0, stream, (const bf16*)(ws + WS_QB), (const bf16*)(ws + WS_KB), (const bf16*)(ws + WS_VB), (const float*)(ws + WS_KMEAN), a.p.rel_bias, (bf16*)(ws + WS_O));
#if MK_PROBE_DUMP
    for (int ph = 4; ph < MK_PROBE_DUMP; ph += 1) { a.ph_lo = ph; a.ph_hi = ph + 1; hipLaunchKernelGGL(mk_fwd, dim3(grid), dim3(NWAVES * 64), LDS_BYTES, stream, a); a.li++; }
    hipLaunchKernelGGL(k_dump, dim3(M * D / 256), dim3(256), 0, stream, (const bf16*)(ws + MK_PROBE_SRC), (float*)d_out);
    return;
#endif
    for (int ph = 4; ph < 9; ph += MK_PH_STEP) { a.ph_lo = ph; a.ph_hi = (ph + MK_PH_STEP < 9) ? ph + MK_PH_STEP : 9; hipLaunchKernelGGL(mk_fwd, dim3(grid), dim3(NWAVES * 64), LDS_BYTES, stream, a); a.li++; }
#else
    a.ph_lo = 0; a.ph_hi = 9; a.li = 0; a.pad = 0;
    hipLaunchKernelGGL(mk_fwd, dim3(grid), dim3(NWAVES * 64), LDS_BYTES, stream, a);
#endif
}
```

```cpp
#include <hip/hip_runtime.h>
#include <cstdio>
#include <cstdint>
#include <cmath>

#ifndef MK_SIMPLE_ATTN
#define MK_SIMPLE_ATTN 0
#endif
#ifndef MK_PH_STEP
#define MK_PH_STEP 16
#endif

#ifndef MK_PROBE_DUMP
#define MK_PROBE_DUMP 0
#endif
#ifndef MK_PROBE_SRC
#define MK_PROBE_SRC WS_O
#endif

namespace pg8 {
#define PG8_LAS __attribute__((address_space(3)))
typedef unsigned short bf16_t;
typedef short bf16x8 __attribute__((ext_vector_type(8)));
typedef float f32x4 __attribute__((ext_vector_type(4)));
typedef unsigned u32x4 __attribute__((ext_vector_type(4)));
constexpr int BM = 256, BK = 64, HALF = 128, HTB = HALF * BK * 2  , STAGE_BYTES = 8 * HTB, NXCD = 8, WGM = 8;

__host__ __device__ __forceinline__ int lds_byte(int r, int c) { const int st = (r >> 4) * 2 + (c >> 5), rr = r & 15, cc = c & 31, ob = rr * 64 + cc * 2; return st * 1024 + (ob ^ (((ob >> 9) & 1) << 5)); }
__host__ __device__ __forceinline__ void stage_rc(int b, int& R, int& C) { const int st = b / 1024, sb = b % 1024, swz = sb ^ (((sb >> 9) & 1) << 5); R = (st >> 1) * 16 + swz / 64; C = (st & 1) * 32 + (swz % 64) / 2; }
__host__ __device__ __forceinline__ int perm32(int rho) { const int n = rho >> 4, i = rho & 15; return 8 * (i >> 2) + 4 * n + (i & 3); }

struct Unit { int pm, pn, koff, pass; };
struct Gemm { const bf16_t* A; const bf16_t* Bt; int K, ld; };

struct StaticOrder {
    int nM, nN, nwg, G, c;
    __host__ __device__ void init(int M, int N, int G_, int c_) { nM = M / BM; nN = N / BM; nwg = nM * nN; G = G_; c = c_; }
    __host__ __device__ bool next(int i, Unit& u) const {
        const long L = (long)i * G + c; if (L >= nwg) return false;
        int wgid = (int)L; { const int q = nwg / NXCD, r = nwg % NXCD, xcd = wgid % NXCD, off = wgid / NXCD; wgid = (xcd < r ? xcd * (q + 1) : r * (q + 1) + (xcd - r) * q) + off; }
        const int nig = WGM * nN, gid = wgid / nig, fm = gid * WGM, gsz = (nM - fm) < WGM ? (nM - fm) : WGM;
        u.pm = fm + ((wgid % nig) % gsz); u.pn = (wgid % nig) / gsz; u.koff = 0; u.pass = 0; return true;
    }
    __device__ __forceinline__ void a_ready(const Unit&) const {}
    __device__ __forceinline__ void done(const Unit&) const {}
};


typedef float f32x2_t __attribute__((ext_vector_type(2))); typedef __bf16 bf16x2_t __attribute__((ext_vector_type(2)));
__device__ __forceinline__ unsigned cvt_pk_bf16(float lo, float hi) { const f32x2_t v = {lo, hi}; const bf16x2_t b = __builtin_convertvector(v, bf16x2_t); return __builtin_bit_cast(unsigned, b); }
__device__ __forceinline__ float bf_lo(unsigned w) { return __uint_as_float(w << 16); }
__device__ __forceinline__ float bf_hi(unsigned w) { return __uint_as_float(w & 0xffff0000u); }
__device__ __forceinline__ float sigmoidf_fast(float v) { return __builtin_amdgcn_rcpf(1.0f + __builtin_amdgcn_exp2f(-1.4426950408889634f * v)); }
#ifndef MK_PROBE_TREAD
#define MK_PROBE_TREAD 1
#endif
#ifndef MK_PROBE_GMODE
#define MK_PROBE_GMODE 2
#endif
constexpr float QSCALE = 0.125f * 1.4426950408889634f;

struct EpiProj {
    static constexpr bool PERM = true, AFTER_DRAIN = false;
    bf16_t *QA, *KA, *VA, *QB, *KB, *VB, *GA, *GB; float* kmean;
    __device__ __forceinline__ void operator()(const f32x4 (&acc)[2][2][4][2], const Unit& u, int wr, int wc, int fr, int fq) const {
        const int pn = u.pn, row0 = u.pm * BM + wr * 64 + fr, cw = wc * 32 + 8 * fq;
#pragma unroll
        for (int bj = 0; bj < 2; ++bj) {
            bf16_t* dst; int ldc, colb, mode;
            if (pn < 2)       { dst = QA; ldc = 512;  colb = pn * 256 + bj * HALF; mode = 1; }
            else if (pn == 2) { dst = bj ? VA : KA; ldc = 128; colb = 0; mode = 0; }
            else if (pn < 5)  { dst = QB; ldc = 512;  colb = (pn - 3) * 256 + bj * HALF; mode = 1; }
            else if (pn < 7)  { dst = KB; ldc = 512;  colb = (pn - 5) * 256 + bj * HALF; mode = 0; }
            else if (pn < 9)  { dst = VB; ldc = 512;  colb = (pn - 7) * 256 + bj * HALF; mode = 0; }
            else if (pn < 13) { dst = GA; ldc = 1024; colb = (pn - 9) * 256 + bj * HALF; mode = MK_PROBE_GMODE; }
            else              { dst = GB; ldc = 1024; colb = (pn - 13) * 256 + bj * HALF; mode = MK_PROBE_GMODE; }
            bf16_t* base = dst + (size_t)row0 * ldc + colb + cw;
            if (mode == 2) {
#pragma unroll
                for (int ai = 0; ai < 2; ++ai)
#pragma unroll
                    for (int m = 0; m < 4; ++m) { const f32x4 v0 = acc[ai][bj][m][0], v1 = acc[ai][bj][m][1]; u32x4 w;
                        w.x = cvt_pk_bf16(sigmoidf_fast(v0[0]), sigmoidf_fast(v0[1])); w.y = cvt_pk_bf16(sigmoidf_fast(v0[2]), sigmoidf_fast(v0[3]));
                        w.z = cvt_pk_bf16(sigmoidf_fast(v1[0]), sigmoidf_fast(v1[1])); w.w = cvt_pk_bf16(sigmoidf_fast(v1[2]), sigmoidf_fast(v1[3]));
                        *(u32x4*)(base + (size_t)(ai * HALF + m * 16) * ldc) = w; }
            } else {
                const float sc = mode == 1 ? QSCALE : 1.0f;
#pragma unroll
                for (int ai = 0; ai < 2; ++ai)
#pragma unroll
                    for (int m = 0; m < 4; ++m) { const f32x4 v0 = acc[ai][bj][m][0] * sc, v1 = acc[ai][bj][m][1] * sc; u32x4 w;
                        w.x = cvt_pk_bf16(v0[0], v0[1]); w.y = cvt_pk_bf16(v0[2], v0[3]); w.z = cvt_pk_bf16(v1[0], v1[1]); w.w = cvt_pk_bf16(v1[2], v1[3]);
                        *(u32x4*)(base + (size_t)(ai * HALF + m * 16) * ldc) = w; }
            }
        }
        if (pn == 5 || pn == 6) {
            float* km = kmean + (size_t)u.pm * 512;
#pragma unroll
            for (int bj = 0; bj < 2; ++bj)
#pragma unroll
                for (int n = 0; n < 2; ++n)
#pragma unroll
                    for (int j = 0; j < 4; ++j) { float s = 0.f;
#pragma unroll
                        for (int ai = 0; ai < 2; ++ai)
#pragma unroll
                            for (int m = 0; m < 4; ++m) s += acc[ai][bj][m][n][j];
                        s += __shfl_xor(s, 1); s += __shfl_xor(s, 2); s += __shfl_xor(s, 4); s += __shfl_xor(s, 8);
                        if (fr == 0) atomicAdd(km + (pn - 5) * 256 + bj * HALF + cw + 4 * n + j, s * (1.0f / 256.0f)); }
        }
    }
};

struct EpiBranch {
    static constexpr bool PERM = true, AFTER_DRAIN = false;
    bf16_t* wsb; long offGA, offGB, offT, offMG;
    __device__ __forceinline__ void operator()(const f32x4 (&acc)[2][2][4][2], const Unit& u, int wr, int wc, int fr, int fq) const {
        const int row0 = u.pm * BM + wr * 64 + fr, col0 = u.pn * BM + wc * 32 + 8 * fq;
        const bf16_t* G = wsb + (u.pass ? offGB : offGA); const bf16_t* T = wsb + offT; bf16_t* dst = wsb + (u.pass ? offMG : offT);
#pragma unroll
        for (int ai = 0; ai < 2; ++ai)
#pragma unroll
            for (int m = 0; m < 4; ++m)
#pragma unroll
                for (int bj = 0; bj < 2; ++bj) {
                    const size_t off = (size_t)(row0 + ai * HALF + m * 16) * 1024 + col0 + bj * HALF;
                    const u32x4 g = *(const u32x4*)(G + off); const f32x4 v0 = acc[ai][bj][m][0], v1 = acc[ai][bj][m][1];
                    float o[8] = { bf_lo(g.x) * v0[0], bf_hi(g.x) * v0[1], bf_lo(g.y) * v0[2], bf_hi(g.y) * v0[3], bf_lo(g.z) * v1[0], bf_hi(g.z) * v1[1], bf_lo(g.w) * v1[2], bf_hi(g.w) * v1[3] };
                    if (u.pass && MK_PROBE_TREAD) { const u32x4 t = *(const u32x4*)(T + off);
                        o[0] += bf_lo(t.x); o[1] += bf_hi(t.x); o[2] += bf_lo(t.y); o[3] += bf_hi(t.y); o[4] += bf_lo(t.z); o[5] += bf_hi(t.z); o[6] += bf_lo(t.w); o[7] += bf_hi(t.w); }
                    u32x4 w; w.x = cvt_pk_bf16(o[0], o[1]); w.y = cvt_pk_bf16(o[2], o[3]); w.z = cvt_pk_bf16(o[4], o[5]); w.w = cvt_pk_bf16(o[6], o[7]);
                    *(u32x4*)(dst + off) = w; }
    }
};

__device__ __forceinline__ void tile_row_sumsq(const float (&ss)[2][4], float* SSrow  , int wr, int wc, int fr, int fq, PG8_LAS unsigned char* lds) {
    PG8_LAS float* P = (PG8_LAS float*)lds;
#pragma unroll
    for (int ai = 0; ai < 2; ++ai)
#pragma unroll
        for (int m = 0; m < 4; ++m) { float s = ss[ai][m]; s += __shfl_xor(s, 16); s += __shfl_xor(s, 32);
            if (fq == 0) P[(ai * HALF + wr * 64 + m * 16 + fr) * 4 + wc] = s; }
    asm volatile("s_waitcnt lgkmcnt(0)" ::: "memory"); __builtin_amdgcn_s_barrier(); asm volatile("" ::: "memory");
    const int t = threadIdx.x;
    if (t < 256) { const PG8_LAS float* p = P + t * 4; SSrow[t] = (p[0] + p[1]) + (p[2] + p[3]); }
}

struct EpiOut {
    static constexpr bool PERM = false, AFTER_DRAIN = true;
    const float* x; float* X1; bf16_t* A6; const float* mod; const float* g2; float* SS;
    __device__ __forceinline__ void fused(f32x4 (&acc)[2][2][4][2], const Unit& u, int wr, int wc, int fr, int fq, PG8_LAS unsigned char* lds, int wid, int lane) const {
        typedef unsigned u32x2v __attribute__((ext_vector_type(2)));
        const int b = u.pm >> 4, col0 = u.pn * BM + wc * 32 + 4 * fq;
        const float* mb = mod + (size_t)b * 6144;
        f32x4 g1[2][2], gm[2][2];
#pragma unroll
        for (int bj = 0; bj < 2; ++bj)
#pragma unroll
            for (int n = 0; n < 2; ++n) { const int c = col0 + bj * HALF + n * 16; g1[bj][n] = *(const f32x4*)(mb + 2 * 1024 + c);
                gm[bj][n] = *(const f32x4*)(g2 + c) * (*(const f32x4*)(mb + 4 * 1024 + c) + 1.0f); }
        float ss[2][4];
#pragma unroll
        for (int ai = 0; ai < 2; ++ai)
#pragma unroll
            for (int m = 0; m < 4; ++m) { const size_t off = (size_t)(u.pm * BM + ai * HALF + wr * 64 + m * 16 + fr) * 1024 + col0; float s = 0.f;
#pragma unroll
                for (int bj = 0; bj < 2; ++bj)
#pragma unroll
                    for (int n = 0; n < 2; ++n) { const f32x4 xv = *(const f32x4*)(x + off + bj * HALF + n * 16); const f32x4 x1 = xv + g1[bj][n] * acc[ai][bj][m][n];
                        *(f32x4*)(X1 + off + bj * HALF + n * 16) = x1; s += (x1[0] * x1[0] + x1[1] * x1[1]) + (x1[2] * x1[2] + x1[3] * x1[3]);
                        const f32x4 a = x1 * gm[bj][n]; u32x2v w; w.x = cvt_pk_bf16(a[0], a[1]); w.y = cvt_pk_bf16(a[2], a[3]); *(u32x2v*)(A6 + off + bj * HALF + n * 16) = w; }
                ss[ai][m] = s; if (m & 1) asm volatile("" ::: "memory"); }
        tile_row_sumsq(ss, SS + (size_t)u.pn * 16384 + (size_t)u.pm * BM, wr, wc, fr, fq, lds);
    }
};

struct EpiMlpIn {
    static constexpr bool PERM = true, AFTER_DRAIN = false;
    bf16_t* ACT; const float* SS; const float* bias2;
    __device__ __forceinline__ void operator()(const f32x4 (&acc)[2][2][4][2], const Unit& u, int wr, int wc, int fr, int fq) const {
        const int b = u.pm >> 4, row0 = u.pm * BM + wr * 64 + fr, col0 = u.pn * BM + wc * 32 + 8 * fq;
        f32x4 bv[2][2];
#pragma unroll
        for (int bj = 0; bj < 2; ++bj)
#pragma unroll
            for (int n = 0; n < 2; ++n) bv[bj][n] = *(const f32x4*)(bias2 + (size_t)b * 4096 + col0 + bj * HALF + 4 * n);
#pragma unroll
        for (int ai = 0; ai < 2; ++ai)
#pragma unroll
            for (int m = 0; m < 4; ++m) { const int row = row0 + ai * HALF + m * 16;
                const float sq = (SS[row] + SS[16384 + row]) + (SS[2 * 16384 + row] + SS[3 * 16384 + row]);
                const float rs = __builtin_amdgcn_rsqf(sq * (1.0f / 1024.0f) + 1e-6f);
                bf16_t* rowp = ACT + (size_t)row * 4096 + col0;
#pragma unroll
                for (int bj = 0; bj < 2; ++bj) { f32x4 v0 = acc[ai][bj][m][0] * rs + bv[bj][0], v1 = acc[ai][bj][m][1] * rs + bv[bj][1];
                    v0 = __builtin_elementwise_max(v0, (f32x4){0.f, 0.f, 0.f, 0.f}); v1 = __builtin_elementwise_max(v1, (f32x4){0.f, 0.f, 0.f, 0.f}); v0 = v0 * v0; v1 = v1 * v1;
                    u32x4 w; w.x = cvt_pk_bf16(v0[0], v0[1]); w.y = cvt_pk_bf16(v0[2], v0[3]); w.z = cvt_pk_bf16(v1[0], v1[1]); w.w = cvt_pk_bf16(v1[2], v1[3]);
                    *(u32x4*)(rowp + bj * HALF) = w; } }
    }
};

struct EpiMlpOut {
    static constexpr bool PERM = false, AFTER_DRAIN = true;
    float* X; const float* mod; float* SS2;
    __device__ __forceinline__ void fused(f32x4 (&acc)[2][2][4][2], const Unit& u, int wr, int wc, int fr, int fq, PG8_LAS unsigned char* lds, int wid, int lane) const {
        const int b = u.pm >> 4, col0 = u.pn * BM + wc * 32 + 4 * fq;
        const float* mb = mod + (size_t)b * 6144 + 5 * 1024;
        f32x4 g2v[2][2];
#pragma unroll
        for (int bj = 0; bj < 2; ++bj)
#pragma unroll
            for (int n = 0; n < 2; ++n) g2v[bj][n] = *(const f32x4*)(mb + col0 + bj * HALF + n * 16);
        float ss[2][4];
#pragma unroll
        for (int ai = 0; ai < 2; ++ai)
#pragma unroll
            for (int m = 0; m < 4; ++m) { const size_t off = (size_t)(u.pm * BM + ai * HALF + wr * 64 + m * 16 + fr) * 1024 + col0; float s = 0.f;
#pragma unroll
                for (int bj = 0; bj < 2; ++bj)
#pragma unroll
                    for (int n = 0; n < 2; ++n) { const f32x4 xv = *(const f32x4*)(X + off + bj * HALF + n * 16); const f32x4 x2 = xv + g2v[bj][n] * acc[ai][bj][m][n];
                        *(f32x4*)(X + off + bj * HALF + n * 16) = x2; s += (x2[0] * x2[0] + x2[1] * x2[1]) + (x2[2] * x2[2] + x2[3] * x2[3]); }
                ss[ai][m] = s; if (m & 1) asm volatile("" ::: "memory"); }
        tile_row_sumsq(ss, SS2 + (size_t)u.pn * 16384 + (size_t)u.pm * BM, wr, wc, fr, fq, lds);
    }
};

struct BranchOrder {
    StaticOrder S;
    __device__ __forceinline__ bool next(int i, Unit& u) const { if (i >= 2) return false; const bool ok = S.next(0, u); u.koff = 512 * i; u.pass = i; return ok; }
    __device__ __forceinline__ void a_ready(const Unit&) const {}
    __device__ __forceinline__ void done(const Unit&) const {}
};

template <class Epi, class Sched, bool ALIGN_EPI = false, bool SP2 = false>
__device__ __forceinline__ void gemm_phase(PG8_LAS unsigned char* lds, const Gemm g, const Sched& S, const Epi& E) {
    const int tid = threadIdx.x, wid = __builtin_amdgcn_readfirstlane(tid >> 6), lane = tid & 63, wr = wid >> 2, wc = wid & 3, fr = lane & 15, fq = lane >> 4;
    const int K = g.K, nt = K / BK, ld = g.ld;
    unsigned voffA[2], voffB[2];
#pragma unroll
    for (int i = 0; i < 2; ++i) { int R, C; stage_rc(tid * 16 + i * 8192, R, C); const int Rb = Epi::PERM ? ((R & ~31) + perm32(R & 31)) : R;
        voffA[i] = (unsigned)(R * ld + C) * 2u; voffB[i] = (unsigned)(Rb * ld + C) * 2u; }
    const size_t kstep = (size_t)(BK * 2);
    const size_t hstep = (size_t)HALF * ld * 2;
    const size_t tstep = 2 * hstep;
    const unsigned ldsw = (unsigned)wid * 1024u;
    const int aoff = lds_byte(wr * 64 + fr, fq * 8), boff = lds_byte(wc * 32 + fr, fq * 8);
#define PG8_SA(b, h) (((b) * 2 + (h)) * HTB)
#define PG8_SB(b, h) ((4 + (b) * 2 + (h)) * HTB)
#define PG8_STAGE(bufoff, gbase, voff) do { _Pragma("unroll") for (int _i = 0; _i < 2; ++_i) \
        __builtin_amdgcn_global_load_lds((const unsigned*)((const char*)(gbase) + (voff)[_i]), (PG8_LAS unsigned*)(lds + (bufoff) + ldsw + _i * 8192), 16, 0, 0); } while (0)
#define PG8_LDA(dst, b, h) do { _Pragma("unroll") for (int m = 0; m < 4; ++m) _Pragma("unroll") for (int k = 0; k < 2; ++k) dst[m][k] = *(const PG8_LAS bf16x8*)(lds + PG8_SA(b, h) + aoff + m * 2048 + k * 1024); } while (0)
#define PG8_LDB(dst, b, h) do { _Pragma("unroll") for (int n = 0; n < 2; ++n) _Pragma("unroll") for (int k = 0; k < 2; ++k) dst[n][k] = *(const PG8_LAS bf16x8*)(lds + PG8_SB(b, h) + boff + n * 2048 + k * 1024); } while (0)
#define PG8_MMA(ai, bj, At, Bt) do { __builtin_amdgcn_s_setprio(1); _Pragma("unroll") for (int m = 0; m < 4; ++m) _Pragma("unroll") for (int n = 0; n < 2; ++n) _Pragma("unroll") for (int k = 0; k < 2; ++k) \
        acc[ai][bj][m][n] = __builtin_amdgcn_mfma_f32_16x16x32_bf16(Bt[n][k], At[m][k], acc[ai][bj][m][n], 0, 0, 0); __builtin_amdgcn_s_setprio(0); } while (0)
#define PG8_WAIT_V(n) asm volatile("s_waitcnt vmcnt(" #n ")" ::: "memory")
#define PG8_WAIT_L(n) asm volatile("s_waitcnt lgkmcnt(" #n ")" ::: "memory")
#define PG8_BAR __builtin_amdgcn_s_barrier()
#define PG8_SCHED __builtin_amdgcn_sched_barrier(0)
    Unit cur, nxt; int ui = 0;
    if (!S.next(0, cur)) return;
    f32x4 acc[2][2][4][2];
#pragma unroll
    for (int a = 0; a < 2; ++a)
#pragma unroll
        for (int b = 0; b < 2; ++b)
#pragma unroll
            for (int m = 0; m < 4; ++m)
#pragma unroll
                for (int n = 0; n < 2; ++n) acc[a][b][m][n] = (f32x4){0.f, 0.f, 0.f, 0.f};
    bf16x8 At[4][2], B0[2][2], B1[2][2];
    const char* cA = (const char*)g.A + (size_t)cur.pm * tstep + (size_t)cur.koff * 2; const char* cB = (const char*)g.Bt + (size_t)cur.pn * tstep + (size_t)cur.koff * 2;
    S.a_ready(cur);
    if constexpr (SP2) {
        PG8_STAGE(PG8_SB(0, 0), cB, voffB); PG8_STAGE(PG8_SB(0, 1), cB + hstep, voffB); PG8_STAGE(PG8_SA(0, 0), cA, voffA); PG8_STAGE(PG8_SA(0, 1), cA + hstep, voffA);
        if (wr == 1) PG8_BAR;
        PG8_WAIT_V(2); PG8_BAR;
        PG8_STAGE(PG8_SB(1, 0), cB + kstep, voffB); PG8_STAGE(PG8_SA(1, 0), cA + kstep, voffA); PG8_STAGE(PG8_SB(1, 1), cB + hstep + kstep, voffB);
        PG8_WAIT_V(6); PG8_BAR;
    } else {
        PG8_STAGE(PG8_SB(0, 0), cB, voffB); PG8_STAGE(PG8_SA(0, 0), cA, voffA); PG8_STAGE(PG8_SB(0, 1), cB + hstep, voffB); PG8_STAGE(PG8_SA(0, 1), cA + hstep, voffA);
        if (wr == 1) PG8_BAR;
        PG8_WAIT_V(4); PG8_BAR;
        PG8_STAGE(PG8_SB(1, 0), cB + kstep, voffB); PG8_STAGE(PG8_SA(1, 0), cA + kstep, voffA); PG8_STAGE(PG8_SB(1, 1), cB + hstep + kstep, voffB);
        PG8_WAIT_V(6); PG8_BAR;
    }
    for (;;) {
        const bool has_next = S.next(ui + 1, nxt);
        const char* nA = has_next ? (const char*)g.A + (size_t)nxt.pm * tstep + (size_t)nxt.koff * 2 : cA; const char* nB = has_next ? (const char*)g.Bt + (size_t)nxt.pn * tstep + (size_t)nxt.koff * 2 : cB;
        for (int t = 0; t < nt; t += 2) {
            const bool last = (t == nt - 2);
            const char* a1 = cA + (size_t)(t + 1) * kstep;
            const char* a2 = last ? nA : cA + (size_t)(t + 2) * kstep; const char* b2 = last ? nB : cB + (size_t)(t + 2) * kstep;
            const char* a3 = a2 + kstep; const char* b3 = b2 + kstep;
            if (last && has_next) S.a_ready(nxt);
            if constexpr (SP2) {
            PG8_LDB(B0, 0, 0); PG8_LDB(B1, 0, 1); PG8_SCHED; PG8_LDA(At, 0, 0); PG8_STAGE(PG8_SA(1, 1), a1 + hstep, voffA);
            PG8_WAIT_V(8); PG8_WAIT_L(0); PG8_BAR; PG8_MMA(0, 0, At, B0); PG8_MMA(0, 1, At, B1); PG8_BAR; PG8_SCHED;
            PG8_LDA(At, 0, 1); PG8_STAGE(PG8_SB(0, 0), b2, voffB); PG8_STAGE(PG8_SB(0, 1), b2 + hstep, voffB); PG8_STAGE(PG8_SA(0, 0), a2, voffA);
            PG8_WAIT_V(8); PG8_WAIT_L(0); PG8_BAR; PG8_MMA(1, 0, At, B0); PG8_MMA(1, 1, At, B1); PG8_BAR; PG8_SCHED;
            PG8_LDB(B0, 1, 0); PG8_LDB(B1, 1, 1); PG8_SCHED; PG8_LDA(At, 1, 0); PG8_STAGE(PG8_SA(0, 1), a2 + hstep, voffA);
            PG8_WAIT_V(8); PG8_WAIT_L(0); PG8_BAR; PG8_MMA(0, 0, At, B0); PG8_MMA(0, 1, At, B1); PG8_BAR; PG8_SCHED;
            PG8_LDA(At, 1, 1); PG8_STAGE(PG8_SB(1, 0), b3, voffB); PG8_STAGE(PG8_SB(1, 1), b3 + hstep, voffB); PG8_STAGE(PG8_SA(1, 0), a3, voffA);
            PG8_WAIT_V(8); PG8_WAIT_L(0); PG8_BAR; PG8_MMA(1, 0, At, B0); PG8_MMA(1, 1, At, B1); PG8_BAR; PG8_SCHED;
            } else {
            PG8_LDB(B0, 0, 0); PG8_SCHED; PG8_LDA(At, 0, 0); PG8_STAGE(PG8_SA(1, 1), a1 + hstep, voffA);
            PG8_WAIT_L(8); PG8_BAR; PG8_WAIT_L(0); PG8_MMA(0, 0, At, B0); PG8_BAR; PG8_SCHED;
            PG8_LDB(B1, 0, 1); PG8_STAGE(PG8_SB(0, 0), b2, voffB);
            PG8_BAR; PG8_WAIT_L(0); PG8_MMA(0, 1, At, B1); PG8_BAR;
            PG8_LDA(At, 0, 1); PG8_STAGE(PG8_SA(0, 0), a2, voffA);
            PG8_BAR; PG8_WAIT_L(0); PG8_MMA(1, 0, At, B0); PG8_BAR; PG8_SCHED;
            PG8_STAGE(PG8_SB(0, 1), b2 + hstep, voffB);
            PG8_WAIT_V(6); PG8_BAR; PG8_MMA(1, 1, At, B1); PG8_BAR;
            PG8_LDB(B0, 1, 0); PG8_SCHED; PG8_LDA(At, 1, 0); PG8_STAGE(PG8_SA(0, 1), a2 + hstep, voffA);
            PG8_WAIT_L(8); PG8_BAR; PG8_WAIT_L(0); PG8_MMA(0, 0, At, B0); PG8_BAR; PG8_SCHED;
            PG8_LDB(B1, 1, 1); PG8_STAGE(PG8_SB(1, 0), b3, voffB);
            PG8_BAR; PG8_WAIT_L(0); PG8_MMA(0, 1, At, B1); PG8_BAR;
            PG8_LDA(At, 1, 1); PG8_STAGE(PG8_SA(1, 0), a3, voffA);
            PG8_BAR; PG8_WAIT_L(0); PG8_MMA(1, 0, At, B0); PG8_BAR; PG8_SCHED;
            PG8_STAGE(PG8_SB(1, 1), b3 + hstep, voffB);
            PG8_WAIT_V(6); PG8_BAR; PG8_MMA(1, 1, At, B1); PG8_BAR;
            }
        }
        if constexpr (ALIGN_EPI) { if (wr == 0) PG8_BAR; }
        if constexpr (!Epi::AFTER_DRAIN) { E(acc, cur, wr, wc, fr, fq); S.done(cur); }
        if (!has_next) break;
#pragma unroll
        for (int a = 0; a < 2; ++a)
#pragma unroll
            for (int b = 0; b < 2; ++b)
#pragma unroll
                for (int m = 0; m < 4; ++m)
#pragma unroll
                    for (int n = 0; n < 2; ++n) acc[a][b][m][n] = (f32x4){0.f, 0.f, 0.f, 0.f};
        cur = nxt; cA = nA; cB = nB; ++ui;
        if constexpr (ALIGN_EPI) { if (wr == 1) PG8_BAR; }
    }
    PG8_WAIT_V(0);
    if constexpr (!ALIGN_EPI) { if (wr == 0) PG8_BAR; }
    PG8_BAR;
    if constexpr (Epi::AFTER_DRAIN) { E.fused(acc, cur, wr, wc, fr, fq, lds, wid, lane); S.done(cur); }
#undef PG8_SA
#undef PG8_SB
#undef PG8_STAGE
#undef PG8_LDA
#undef PG8_LDB
#undef PG8_MMA
#undef PG8_WAIT_V
#undef PG8_WAIT_L
#undef PG8_BAR
#undef PG8_SCHED
}
}

#define GAS __attribute__((address_space(1)))
#define LAS __attribute__((address_space(3)))
typedef unsigned short bf16;
typedef unsigned v4u __attribute__((ext_vector_type(4)));
typedef float f32x4 __attribute__((ext_vector_type(4)));
typedef short bf16x8 __attribute__((ext_vector_type(8)));
typedef GAS unsigned gu32;
typedef GAS unsigned long long gu64;
#define RLX_AGENT __ATOMIC_RELAXED, __HIP_MEMORY_SCOPE_AGENT
#define LDS_WAIT() asm volatile("s_waitcnt lgkmcnt(0)" ::: "memory")
#define VM_WAIT() asm volatile("s_waitcnt vmcnt(0)" ::: "memory")
__device__ __forceinline__ unsigned long long rt() { return __builtin_amdgcn_s_memrealtime(); }
__device__ __forceinline__ unsigned f2bf(float f) { unsigned u = __builtin_bit_cast(unsigned, f); return (u + 0x7fffu + ((u >> 16) & 1u)) >> 16; }
__device__ __forceinline__ unsigned pk2(float lo, float hi) { return f2bf(lo) | (f2bf(hi) << 16); }

#define XB_TMO      128
#define XB_XCNT(j)  (256  + 64 * (j))
#define XB_XSUB(j)  (1280 + 64 * (j))
#define XB_XGEN(j)  (2304 + 64 * (j))
#define XB_TOP      3328
#define XB_TOPGEN   3392
#define XCD_BAR_WORDS 3456
#define XB_SPIN_CAP (1u << 18)

__device__ __forceinline__ unsigned xb_ld(unsigned* p)              { return __hip_atomic_load(p, __ATOMIC_RELAXED, __HIP_MEMORY_SCOPE_AGENT); }
__device__ __forceinline__ unsigned xb_add(unsigned* p, unsigned v) { return __hip_atomic_fetch_add(p, v, __ATOMIC_RELAXED, __HIP_MEMORY_SCOPE_AGENT); }
__device__ __forceinline__ unsigned xb_xcc_id() { return (unsigned)__builtin_amdgcn_s_getreg((3 << 11) | 20) & 0xFu; }
#define XB_SPIN(cond, bar) do { unsigned _sp = 0; while (cond) { __builtin_amdgcn_s_sleep(1); \
    if ((++_sp & 255u) == 0u) { if (xb_ld(&(bar)[XB_TMO])) break; if (_sp > XB_SPIN_CAP) { atomicAdd(&(bar)[XB_TMO], 1u); break; } } } } while (0)

struct XcdBarrier {
    unsigned* bar; unsigned x;
    volatile LAS unsigned* st;
};

__device__ __forceinline__ XcdBarrier xcd_barrier_post(unsigned* bar, volatile LAS unsigned* st) {
    XcdBarrier b; b.bar = bar; b.x = xb_xcc_id(); b.st = st;
    if (threadIdx.x == 0) (void)xb_add(&bar[XB_XCNT(b.x)], 1u);
    return b;
}
__device__ __forceinline__ void xcd_barrier_complete(unsigned* bar, unsigned x, unsigned& nloc, unsigned& nx) {
    const unsigned G = gridDim.x * gridDim.y * gridDim.z;
    unsigned sum, cnt, mine, sp = 0u;
    for (;;) {
        sum = 0u; cnt = 0u; mine = 0u;
#pragma unroll
        for (unsigned j = 0; j < 16; ++j) { const unsigned c = xb_ld(&bar[XB_XCNT(j)]); sum += c; cnt += (c > 0u) ? 1u : 0u; mine = (j == x) ? c : mine; }
        if (sum == G) break;
        __builtin_amdgcn_s_sleep(1);
        if ((++sp & 255u) == 0u) { if (xb_ld(&bar[XB_TMO])) break; if (sp > XB_SPIN_CAP) { atomicAdd(&bar[XB_TMO], 1u); break; } }
    }
    nloc = mine > 0u ? mine : 1u; nx = cnt > 0u ? cnt : 1u;
}

__device__ __forceinline__ void xcd_barrier(const XcdBarrier& b) {
    asm volatile("s_waitcnt vmcnt(0)" ::: "memory");
    __syncthreads();
    if (threadIdx.x == 0) {
        unsigned* bar = b.bar;
        __builtin_amdgcn_s_waitcnt(0);
        unsigned nloc = b.st[0], nx = b.st[1];
        if (nloc == 0u) { xcd_barrier_complete(bar, b.x, nloc, nx); b.st[0] = nloc; b.st[1] = nx; }
        const unsigned old = xb_add(&bar[XB_XSUB(b.x)], 1u);
        const unsigned gen = old / nloc;
        if (old + 1u == (gen + 1u) * nloc) {
            __builtin_amdgcn_fence(__ATOMIC_RELEASE, "agent");
            asm volatile("s_waitcnt vmcnt(0)" ::: "memory");
            const unsigned og = xb_add(&bar[XB_TOP], 1u);
            const unsigned tg = og / nx;
            if (og + 1u == (tg + 1u) * nx) xb_add(&bar[XB_TOPGEN], 1u);
            else XB_SPIN(xb_ld(&bar[XB_TOPGEN]) == tg, bar);
            __builtin_amdgcn_fence(__ATOMIC_ACQUIRE, "agent");
            xb_add(&bar[XB_XGEN(b.x)], 1u);
            asm volatile("s_waitcnt vmcnt(0)" ::: "memory");
        } else {
            XB_SPIN(xb_ld(&bar[XB_XGEN(b.x)]) == gen, bar);
            __builtin_amdgcn_fence(__ATOMIC_ACQUIRE, "agent");
            asm volatile("s_waitcnt vmcnt(0)" ::: "memory");
        }
    }
    __syncthreads();
}

constexpr int NWAVES = 8;
constexpr int BATCH = 4, SEQ = 4096, D = 1024, M = BATCH * SEQ, FF = 4096, INTOT = 4352, NMOD = 6;
constexpr float RMS_EPS = 1e-6f;
constexpr float LOG2E = 1.4426950408889634f;
constexpr size_t MiB = 1u << 20;
constexpr size_t WS_CTL = 0, CTL_ZERO_BYTES = 1 * MiB;
constexpr size_t WS_KMEAN = 256 * 1024;
constexpr size_t WS_MOD = 1 * MiB;
constexpr size_t WS_BIAS2 = 1 * MiB + 128 * 1024;
constexpr size_t WS_SS = 1 * MiB + 256 * 1024;
constexpr size_t WS_SS2 = 1 * MiB + 512 * 1024;
constexpr size_t WS_WIN = 2 * MiB, WS_WAB = 11 * MiB, WS_WO = 13 * MiB, WS_W1 = 15 * MiB, WS_W2 = 23 * MiB;
constexpr size_t WS_HA = 32 * MiB;
constexpr size_t WS_QA = 64 * MiB, WS_QB = 80 * MiB, WS_KB = 96 * MiB, WS_VB = 112 * MiB, WS_KA = 128 * MiB, WS_VA = 132 * MiB, WS_GA = 136 * MiB, WS_GB = 168 * MiB;
constexpr size_t WS_O = 200 * MiB;
constexpr size_t WS_MG = 64 * MiB;
constexpr size_t WS_ACT = 64 * MiB;
constexpr size_t WS_MODP = 232 * MiB;
constexpr size_t WS_END = 256 * MiB;
constexpr int CW_TMO = 0, CW_CODE = 1, CW_BAR = 4096;
constexpr int RING_OFF = 0, RING_BYTES = 131072;
constexpr int LDSCTL_OFF = RING_BYTES, MISC_OFF = LDSCTL_OFF + 320, VEC_OFF = RING_BYTES + 1024;
constexpr int LDS_BYTES = 147456;

struct Frame {
    LAS unsigned char* lds;
    volatile LAS unsigned* MISC;
    gu32* ctl;
    int tid, lane, wave, G;
};
__device__ __forceinline__ float wave_sum(float v) {
#pragma unroll
    for (int o = 1; o < 64; o <<= 1) v += __shfl_xor(v, o);
    return v;
}
__device__ __forceinline__ void transpose_item(const float* W, int N, bf16* WT, int ldt, int koff, LAS float* scr, int item, int lane) {
    const int nblk = N / 32, kb = item / nblk, nb = item % nblk, k0 = 64 * kb, n0 = 32 * nb;
#pragma unroll 8
    for (int i = 0; i < 32; ++i) { const int kk = 2 * i + (lane >> 5); scr[kk * 33 + (lane & 31)] = W[(size_t)(k0 + kk) * N + n0 + (lane & 31)]; }
    LDS_WAIT(); asm volatile("" ::: "memory");
    const int c = lane & 7;
#pragma unroll
    for (int j = 0; j < 4; ++j) { const int n = (lane >> 3) + 8 * j; const LAS float* s = scr + (8 * c) * 33 + n;
        v4u o; o.x = pk2(s[0 * 33], s[1 * 33]); o.y = pk2(s[2 * 33], s[3 * 33]); o.z = pk2(s[4 * 33], s[5 * 33]); o.w = pk2(s[6 * 33], s[7 * 33]);
        *(GAS v4u*)(WT + (size_t)(n0 + n) * ldt + koff + k0 + 8 * c) = o; }
    LDS_WAIT(); asm volatile("" ::: "memory");
}

struct Ptrs {
    const float *x, *c, *ada_w, *ada_b, *n1g, *n2g, *w_in, *sinks, *rel_bias, *wa, *wb, *wo, *w1, *w2, *fg;
    float* out; unsigned char* ws;
};

__device__ __forceinline__ void p0_mod_partial(Frame& F, const Ptrs& P) {
    LAS float* sl = (LAS float*)(F.lds + RING_OFF);
    LAS float* red = (LAS float*)(F.lds + RING_OFF + 4096);
    const int j = blockIdx.x, cb = j & 15, ks = j >> 4;
    if (F.tid < 256) { const int b = F.tid >> 6, k = F.tid & 63; const float cv = P.c[b * D + ks * 64 + k]; sl[F.tid] = cv / (1.0f + __expf(-cv)); }
    __syncthreads();
    float acc[4][6];
#pragma unroll
    for (int b = 0; b < 4; ++b)
#pragma unroll
        for (int q = 0; q < 6; ++q) acc[b][q] = 0.f;
    const float* wbase = P.ada_w + (size_t)(ks * 64 + F.wave * 8) * (NMOD * D) + cb * 384 + F.lane;
#pragma unroll
    for (int r = 0; r < 8; ++r) { float wv[6];
#pragma unroll
        for (int q = 0; q < 6; ++q) wv[q] = wbase[(size_t)r * (NMOD * D) + 64 * q];
#pragma unroll
        for (int b = 0; b < 4; ++b) { const float s = sl[b * 64 + F.wave * 8 + r];
#pragma unroll
            for (int q = 0; q < 6; ++q) acc[b][q] += s * wv[q]; } }
#pragma unroll
    for (int b = 0; b < 4; ++b)
#pragma unroll
        for (int q = 0; q < 6; ++q) red[(F.wave * 4 + b) * 384 + 64 * q + F.lane] = acc[b][q];
    __syncthreads();
    float* modp = (float*)(P.ws + WS_MODP);
    for (int idx = F.tid; idx < 4 * 384; idx += NWAVES * 64) { const int b = idx / 384, cc = idx % 384; float s = 0.f;
#pragma unroll
        for (int w = 0; w < 8; ++w) s += red[(w * 4 + b) * 384 + cc];
        modp[((size_t)ks * 4 + b) * (NMOD * D) + cb * 384 + cc] = s; }
    __syncthreads();
}
__device__ __forceinline__ float mod_from_partials(const float* modp, const float* ada_b, int b, int n) {
    float s = ada_b[n];
#pragma unroll
    for (int ks = 0; ks < 16; ++ks) s += modp[((size_t)ks * 4 + b) * (NMOD * D) + n];
    return s;
}
__device__ __forceinline__ void p1_prologue(Frame& F, const Ptrs& P) {
    const float* modp = (const float*)(P.ws + WS_MODP);
    float* mod = (float*)(P.ws + WS_MOD);
    const int j = blockIdx.x;
    if (F.tid < 96) { const int i = j * 96 + F.tid; mod[i] = mod_from_partials(modp, P.ada_b, i / (NMOD * D), i % (NMOD * D)); }
    if (F.tid < 128) ((float*)(P.ws + WS_KMEAN))[j * 128 + F.tid] = 0.f;
    LAS float* gm1 = (LAS float*)(F.lds + VEC_OFF); LAS float* sh1 = gm1 + D;
    { const int b = j >> 6;
      for (int d = F.tid; d < D; d += NWAVES * 64) { gm1[d] = P.n1g[d] * (1.0f + mod_from_partials(modp, P.ada_b, b, D + d)); sh1[d] = mod_from_partials(modp, P.ada_b, b, d); } }
    LAS float* scr = (LAS float*)(F.lds + RING_OFF + F.wave * 16384);
    const int gw = j * NWAVES + F.wave, NGW = F.G * NWAVES;
    constexpr int I_IN = (D / 64) * (INTOT / 32), I_A = (512 / 64) * (D / 32), I_O = (D / 64) * (D / 32), I_1 = (D / 64) * (FF / 32), I_2 = (FF / 64) * (D / 32);
    constexpr int NITEMS = I_IN + 2 * I_A + I_O + I_1 + I_2;
    bf16* WIN = (bf16*)(P.ws + WS_WIN); bf16* WAB = (bf16*)(P.ws + WS_WAB); bf16* WO = (bf16*)(P.ws + WS_WO); bf16* W1 = (bf16*)(P.ws + WS_W1); bf16* W2 = (bf16*)(P.ws + WS_W2);
    for (int it = gw; it < NITEMS; it += NGW) {
        int r = it;
        if (r < I_IN) { transpose_item(P.w_in, INTOT, WIN, D, 0, scr, r, F.lane); continue; } r -= I_IN;
        if (r < I_A) { transpose_item(P.wa, D, WAB, D, 0, scr, r, F.lane); continue; } r -= I_A;
        if (r < I_A) { transpose_item(P.wb, D, WAB, D, 512, scr, r, F.lane); continue; } r -= I_A;
        if (r < I_O) { transpose_item(P.wo, D, WO, D, 0, scr, r, F.lane); continue; } r -= I_O;
        if (r < I_1) { transpose_item(P.w1, FF, W1, D, 0, scr, r, F.lane); continue; } r -= I_1;
        transpose_item(P.w2, D, W2, FF, 0, scr, r, F.lane);
    }
    __syncthreads();
    bf16* HA = (bf16*)(P.ws + WS_HA);
    for (int r = 0; r < 8; ++r) {
        const int row = j * 64 + F.wave * 8 + r;
        const GAS f32x4* xr = (const GAS f32x4*)(P.x + (size_t)row * D) + F.lane;
        f32x4 v[4]; float s = 0.f;
#pragma unroll
        for (int q = 0; q < 4; ++q) { v[q] = xr[64 * q]; s += (v[q].x * v[q].x + v[q].y * v[q].y) + (v[q].z * v[q].z + v[q].w * v[q].w); }
        const float rstd = 1.0f / sqrtf(wave_sum(s) * (1.0f / D) + RMS_EPS);
        GAS unsigned long long* o8 = (GAS unsigned long long*)(HA + (size_t)row * D) + F.lane;
#pragma unroll
        for (int q = 0; q < 4; ++q) { const int c0 = 4 * F.lane + 256 * q;
            const f32x4 g = *(const LAS f32x4*)(gm1 + c0), sh = *(const LAS f32x4*)(sh1 + c0); const f32x4 h = v[q] * rstd * g + sh;
            o8[64 * q] = (unsigned long long)pk2(h.x, h.y) | ((unsigned long long)pk2(h.z, h.w) << 32); }
    }
}
__device__ __forceinline__ void p2_bias2(Frame& F, const Ptrs& P) {
    LAS float* sh2 = (LAS float*)(F.lds + RING_OFF);
    const float* mod = (const float*)(P.ws + WS_MOD);
    for (int i = F.tid; i < 4 * D; i += NWAVES * 64) sh2[i] = mod[(size_t)(i >> 10) * (NMOD * D) + 3 * D + (i & 1023)];
    __syncthreads();
    const bf16* W1 = (const bf16*)(P.ws + WS_W1); float* bias2 = (float*)(P.ws + WS_BIAS2);
#pragma unroll
    for (int q = 0; q < 2; ++q) {
        const int n = blockIdx.x * 16 + F.wave * 2 + q;
        const v4u w0 = *(const GAS v4u*)(W1 + (size_t)n * D + F.lane * 16), w1v = *(const GAS v4u*)(W1 + (size_t)n * D + F.lane * 16 + 8);
        float wv[16] = { __uint_as_float(w0.x << 16), __uint_as_float(w0.x & 0xffff0000u), __uint_as_float(w0.y << 16), __uint_as_float(w0.y & 0xffff0000u), __uint_as_float(w0.z << 16), __uint_as_float(w0.z & 0xffff0000u), __uint_as_float(w0.w << 16), __uint_as_float(w0.w & 0xffff0000u),
                         __uint_as_float(w1v.x << 16), __uint_as_float(w1v.x & 0xffff0000u), __uint_as_float(w1v.y << 16), __uint_as_float(w1v.y & 0xffff0000u), __uint_as_float(w1v.z << 16), __uint_as_float(w1v.z & 0xffff0000u), __uint_as_float(w1v.w << 16), __uint_as_float(w1v.w & 0xffff0000u) };
#pragma unroll
        for (int b = 0; b < 4; ++b) { float s = 0.f;
#pragma unroll
            for (int e = 0; e < 16; ++e) s += wv[e] * sh2[b * D + F.lane * 16 + e];
            s = wave_sum(s); if (F.lane == 0) bias2[b * FF + n] = s; }
    }
    __syncthreads();
}
__device__ __forceinline__ void p8_final_norm(Frame& F, const Ptrs& P) {
    const float* SS2 = (const float*)(P.ws + WS_SS2);
    const int gw = blockIdx.x * NWAVES + F.wave, NGW = F.G * NWAVES;
    f32x4 g[4];
#pragma unroll
    for (int q = 0; q < 4; ++q) g[q] = *(const GAS f32x4*)(P.fg + 4 * F.lane + 256 * q);
    for (int row = gw; row < M; row += NGW) {
        const float sq = (SS2[row] + SS2[16384 + row]) + (SS2[2 * 16384 + row] + SS2[3 * 16384 + row]);
        const float rstd = 1.0f / sqrtf(sq * (1.0f / D) + RMS_EPS);
        GAS f32x4* xr = (GAS f32x4*)(P.out + (size_t)row * D) + F.lane;
#pragma unroll
        for (int q = 0; q < 4; ++q) { const f32x4 v = xr[64 * q]; xr[64 * q] = v * rstd * g[q]; }
    }
}

namespace at {
typedef short bf16x8 __attribute__((ext_vector_type(8)));
typedef short s16x4 __attribute__((ext_vector_type(4)));
typedef float f32x16 __attribute__((ext_vector_type(16)));
typedef unsigned u32x4 __attribute__((ext_vector_type(4)));
typedef unsigned u32x2 __attribute__((ext_vector_type(2)));
typedef float f32x2_t __attribute__((ext_vector_type(2))); typedef __bf16 bf16x2_t __attribute__((ext_vector_type(2)));
typedef short v4i16_t __attribute__((ext_vector_type(4)));
typedef __attribute__((address_space(3))) const char* lds_cptr;
__device__ __forceinline__ unsigned cvtpk(float lo, float hi) { const f32x2_t v = {lo, hi}; const bf16x2_t b = __builtin_convertvector(v, bf16x2_t); return __builtin_bit_cast(unsigned, b); }
__device__ __forceinline__ int t5_bucket(int d) {
    if (d < 16) return d;
    int b = 16;
    b += (d >= 22); b += (d >= 30); b += (d >= 40); b += (d >= 54); b += (d >= 73); b += (d >= 99); b += (d >= 134); b += (d >= 182);
    b += (d >= 246); b += (d >= 332); b += (d >= 450); b += (d >= 609); b += (d >= 825); b += (d >= 1117); b += (d >= 1513);
    return b;
}
constexpr int L_KV = 0;
constexpr int L_TAB = 65536;
constexpr int L_KM = 86016;
constexpr int L_OST = 94208;
constexpr int OST_STRIDE = 144, OST_BYTES = 32 * OST_STRIDE;
constexpr int MB_I0 = 4127, MB_TABN = 4191;
constexpr int SW_I0 = 255, SW_TABN = 512;
static_assert(L_TAB + MB_TABN * 4 <= L_KM && L_KM + 8192 <= L_OST && L_OST + 8 * OST_BYTES <= 131072, "attention LDS map");

struct Tens { const bf16 *QA, *KA, *VA, *QB, *KB, *VB; bf16* O; const float* kmean; const float* sinks; const float* rel_bias; };

__device__ __forceinline__ void qkt(f32x16& p0, f32x16& p1, lds_cptr Kt, const bf16x8 (&qr)[4], const f32x16& c0, int r32, int hi) {
    const lds_cptr kb = Kt + hi * 1024 + r32 * 16;
#pragma unroll
    for (int d0 = 0; d0 < 4; ++d0) {
        const bf16x8 b0 = *(const __attribute__((address_space(3))) bf16x8*)(kb + d0 * 2048);
        const bf16x8 b1 = *(const __attribute__((address_space(3))) bf16x8*)(kb + d0 * 2048 + 512);
        if (d0 == 0) { p0 = __builtin_amdgcn_mfma_f32_32x32x16_bf16(b0, qr[0], c0, 0, 0, 0); p1 = __builtin_amdgcn_mfma_f32_32x32x16_bf16(b1, qr[0], c0, 0, 0, 0); }
        else { p0 = __builtin_amdgcn_mfma_f32_32x32x16_bf16(b0, qr[d0], p0, 0, 0, 0); p1 = __builtin_amdgcn_mfma_f32_32x32x16_bf16(b1, qr[d0], p1, 0, 0, 0); }
    }
}
__device__ __forceinline__ s16x4 vtr(lds_cptr p) { return __builtin_bit_cast(s16x4, __builtin_amdgcn_ds_read_tr16_b64_v4i16((__attribute__((address_space(3))) v4i16_t*)p)); }

struct Soft { float m, l; f32x16 o[2]; f32x16 negm; bool init; };
__device__ __forceinline__ void soft_init(Soft& s) { s.m = 0.f; s.l = 0.f; s.o[0] = f32x16{}; s.o[1] = f32x16{}; s.negm = f32x16{}; s.init = false; }

__device__ __forceinline__ void tile_step(Soft& s, lds_cptr Kt, lds_cptr Vt, const bf16x8 (&qr)[4], lds_cptr tab, int lane, int r32, int hi) {
    f32x16 p0, p1;
    qkt(p0, p1, Kt, qr, s.negm, r32, hi);
#pragma unroll
    for (int r = 0; r < 16; ++r) { const int c = (r & 3) + 8 * (r >> 2);
        p0[r] += *(const __attribute__((address_space(3))) float*)(tab + 4 * c);
        p1[r] += *(const __attribute__((address_space(3))) float*)(tab + 4 * (c + 32)); }
    float a = fmaxf(fmaxf(p0[0], p0[1]), p1[0]), b = fmaxf(fmaxf(p0[2], p0[3]), p1[1]); a = fmaxf(fmaxf(a, p1[2]), p1[3]);
#pragma unroll
    for (int r = 4; r < 16; r += 4) { a = fmaxf(fmaxf(a, p0[r]), p0[r + 1]); b = fmaxf(fmaxf(b, p0[r + 2]), p0[r + 3]); a = fmaxf(fmaxf(a, p1[r]), p1[r + 1]); b = fmaxf(fmaxf(b, p1[r + 2]), p1[r + 3]); }
    float rm = fmaxf(a, b);
    { auto rr = __builtin_amdgcn_permlane32_swap(__float_as_uint(rm), __float_as_uint(rm), false, false); rm = fmaxf(__uint_as_float(rr[0]), __uint_as_float(rr[1])); }
    const bool grow = s.init ? (rm > 8.0f) : (rm > -INFINITY);
    if (__any(grow)) {
        const float dl = s.init ? fmaxf(rm, 0.f) : ((rm > -INFINITY) ? rm : 0.f);
        s.m += dl;
#pragma unroll
        for (int r = 0; r < 16; ++r) { p0[r] -= dl; p1[r] -= dl; s.negm[r] = -s.m; }
        const float f = __builtin_amdgcn_exp2f(-dl); s.l *= f;
#pragma unroll
        for (int r = 0; r < 16; ++r) { s.o[0][r] *= f; s.o[1][r] *= f; }
    }
    s.init = s.init || (rm > -INFINITY);
    float sum = 0.f;
#pragma unroll
    for (int r = 0; r < 16; ++r) { p0[r] = __builtin_amdgcn_exp2f(p0[r]); p1[r] = __builtin_amdgcn_exp2f(p1[r]); sum += p0[r] + p1[r]; }
    s.l += sum;
    u32x4 pw[4];
    pw[0] = (u32x4){cvtpk(p0[0], p0[1]), cvtpk(p0[2], p0[3]), cvtpk(p0[4], p0[5]), cvtpk(p0[6], p0[7])};
    pw[1] = (u32x4){cvtpk(p0[8], p0[9]), cvtpk(p0[10], p0[11]), cvtpk(p0[12], p0[13]), cvtpk(p0[14], p0[15])};
    pw[2] = (u32x4){cvtpk(p1[0], p1[1]), cvtpk(p1[2], p1[3]), cvtpk(p1[4], p1[5]), cvtpk(p1[6], p1[7])};
    pw[3] = (u32x4){cvtpk(p1[8], p1[9]), cvtpk(p1[10], p1[11]), cvtpk(p1[12], p1[13]), cvtpk(p1[14], p1[15])};
    const lds_cptr vp = Vt + ((lane >> 4) & 1) * 32 + (lane & 3) * 8 + (4 * hi + ((lane & 15) >> 2)) * 64;
#pragma unroll
    for (int d0 = 0; d0 < 2; ++d0)
#pragma unroll
        for (int ks = 0; ks < 4; ++ks) {
            const s16x4 lo = vtr(vp + d0 * 4096 + ks * 1024), hh = vtr(vp + d0 * 4096 + ks * 1024 + 512);
            const bf16x8 vf = (bf16x8){lo[0], lo[1], lo[2], lo[3], hh[0], hh[1], hh[2], hh[3]};
            s.o[d0] = __builtin_amdgcn_mfma_f32_32x32x16_bf16(vf, __builtin_bit_cast(bf16x8, pw[ks]), s.o[d0], 0, 0, 0);
        }
}
__device__ __forceinline__ void finish(Soft& s, float extra_log2, bool has_extra, LAS unsigned char* stg, bf16* Orow0, int lane, int r32, int hi) {
    float l = s.l;
    { auto rr = __builtin_amdgcn_permlane32_swap(__float_as_uint(l), __float_as_uint(l), false, false); l = __uint_as_float(rr[0]) + __uint_as_float(rr[1]); }
    if (has_extra) l += __builtin_amdgcn_exp2f(extra_log2 - s.m);
    const float inv = 1.0f / l;
#pragma unroll
    for (int d0 = 0; d0 < 2; ++d0)
#pragma unroll
        for (int g = 0; g < 4; ++g) { u32x2 w; w.x = cvtpk(s.o[d0][4 * g] * inv, s.o[d0][4 * g + 1] * inv); w.y = cvtpk(s.o[d0][4 * g + 2] * inv, s.o[d0][4 * g + 3] * inv);
            *(LAS u32x2*)(stg + r32 * OST_STRIDE + (32 * d0 + 8 * g + 4 * hi) * 2) = w; }
    asm volatile("s_waitcnt lgkmcnt(0)" ::: "memory");
#pragma unroll
    for (int i = 0; i < 4; ++i) { const int row = i * 8 + (lane >> 3), ch = lane & 7; const u32x4 v = *(const LAS u32x4*)(stg + row * OST_STRIDE + ch * 16); *(u32x4*)(Orow0 + (size_t)row * 1024 + ch * 8) = v; }
    asm volatile("s_waitcnt lgkmcnt(0)" ::: "memory");
}
__device__ __forceinline__ void dma_tile(LAS unsigned char* dst, const bf16* Kg, const bf16* Vg, int ld, int wave, int lane) {
    const bf16* ks = Kg + (size_t)lane * ld + wave * 8;
    const bf16* vs = Vg + (size_t)(16 * (wave & 3) + (lane >> 2)) * ld + (wave >> 2) * 32 + (lane & 3) * 8;
    __builtin_amdgcn_global_load_lds((const unsigned*)ks, (LAS unsigned*)(dst + wave * 1024), 16, 0, 0);
    __builtin_amdgcn_global_load_lds((const unsigned*)vs, (LAS unsigned*)(dst + 8192 + wave * 1024), 16, 0, 0);
}
__device__ __forceinline__ void load_q(bf16x8 (&qr)[4], const bf16* Qrow0  , int ld, int r32, int hi) {
#pragma unroll
    for (int d0 = 0; d0 < 4; ++d0) qr[d0] = *(const bf16x8*)(Qrow0 + (size_t)r32 * ld + d0 * 16 + hi * 8);
}

__device__ __forceinline__ void moba_unit(LAS unsigned char* lds, const Tens& T, int b, int h, int qb, int wave, int lane) {
    const int r32 = lane & 31, hi = lane >> 5;
    const size_t rowbase = (size_t)b * SEQ;
    const int q0 = qb * 256 + wave * 32;
    bf16x8 qr[4]; load_q(qr, T.QB + (rowbase + q0) * 512 + h * 64, 512, r32, hi);
    const bf16* Kg = T.KB + rowbase * 512 + h * 64; const bf16* Vg = T.VB + rowbase * 512 + h * 64;
    const int NT = 4 * (qb + 1);
    dma_tile(lds + L_KV, Kg, Vg, 512, wave, lane);
    if (threadIdx.x < 256) { const int n = threadIdx.x >> 3, c = threadIdx.x & 7; u32x4 wh = {0u, 0u, 0u, 0u}, wl = {0u, 0u, 0u, 0u};
        if (n < qb) { const float* km = T.kmean + ((size_t)(b * 16 + n) * 8 + h) * 64 + c * 8; float v[8], vh[8];
#pragma unroll
            for (int e = 0; e < 8; ++e) { v[e] = km[e]; vh[e] = __uint_as_float(__float_as_uint(v[e]) & 0xffff0000u); }
            wh = (u32x4){cvtpk(vh[0], vh[1]), cvtpk(vh[2], vh[3]), cvtpk(vh[4], vh[5]), cvtpk(vh[6], vh[7])};
            wl = (u32x4){cvtpk(v[0] - vh[0], v[1] - vh[1]), cvtpk(v[2] - vh[2], v[3] - vh[3]), cvtpk(v[4] - vh[4], v[5] - vh[5]), cvtpk(v[6] - vh[6], v[7] - vh[7])}; }
        *(LAS u32x4*)(lds + L_KM + c * 512 + n * 16) = wh; *(LAS u32x4*)(lds + L_KM + 4096 + c * 512 + n * 16) = wl; }
    asm volatile("s_waitcnt vmcnt(0)" ::: "memory"); __syncthreads();
    unsigned selmask = 0u;
    {
        f32x16 g = f32x16{};
        const lds_cptr kb = (lds_cptr)(lds + L_KM) + hi * 512 + r32 * 16;
#pragma unroll
        for (int part = 0; part < 2; ++part)
#pragma unroll
            for (int d0 = 0; d0 < 4; ++d0) { const bf16x8 a = *(const __attribute__((address_space(3))) bf16x8*)(kb + part * 4096 + d0 * 1024); g = __builtin_amdgcn_mfma_f32_32x32x16_bf16(a, qr[d0], g, 0, 0, 0); }
        float v[16]; int nn[16];
#pragma unroll
        for (int r = 0; r < 8; ++r) { const int nb = (r & 3) + 8 * (r >> 2); v[r] = g[r]; nn[r] = nb + 4 * hi; v[8 + r] = __shfl_xor(g[r], 32); nn[8 + r] = nb + 4 * (1 - hi); }
#pragma unroll
        for (int i = 0; i < 16; ++i) if (nn[i] >= qb) v[i] = -INFINITY;
#pragma unroll
        for (int pass = 0; pass < 3; ++pass) {
            float mx = v[0];
#pragma unroll
            for (int i = 1; i < 16; ++i) mx = fmaxf(mx, v[i]);
            int bn = 64;
#pragma unroll
            for (int i = 0; i < 16; ++i) if (v[i] == mx) bn = min(bn, nn[i]);
            if (mx > -INFINITY) { selmask |= 1u << bn;
#pragma unroll
                for (int i = 0; i < 16; ++i) if (nn[i] == bn) v[i] = -INFINITY; }
        }
    }
    Soft s; soft_init(s);
    const lds_cptr tabbase = (lds_cptr)(lds + L_TAB);
    for (int t = 0; t < NT; ++t) {
        LAS unsigned char* cur = lds + L_KV + (t & 1) * 16384;
        if (t + 1 < NT) dma_tile(lds + L_KV + ((t + 1) & 1) * 16384, Kg + (size_t)(t + 1) * 64 * 512, Vg + (size_t)(t + 1) * 64 * 512, 512, wave, lane);
        const int k0 = t * 64, blk = t >> 2;
        const bool own = (blk == qb);
        const bool sel = own || ((selmask >> blk) & 1u);
        if (k0 <= q0 + 31 && __any(sel)) {
            const int dist0 = q0 - k0 + r32 - 4 * hi;
            const int idx = sel ? (MB_I0 - dist0) : (MB_I0 + 1);
            tile_step(s, (lds_cptr)cur, (lds_cptr)cur + 8192, qr, tabbase + 4 * idx, lane, r32, hi);
        }
        asm volatile("s_waitcnt vmcnt(0)" ::: "memory"); __syncthreads();
    }
    finish(s, 0.f, false, lds + L_OST + wave * OST_BYTES, T.O + (rowbase + q0) * 1024 + 512 + h * 64, lane, r32, hi);
}
__device__ __forceinline__ void swa_unit(LAS unsigned char* lds, const Tens& T, int b, int kvh, int blk, int wave, int lane) {
    const int r32 = lane & 31, hi = lane >> 5;
    const size_t rowbase = (size_t)b * SEQ;
    const int kstart = blk * 128 - 128;
    const int t_lo = (blk == 0) ? 2 : 0;
    for (int t = t_lo; t < 4; ++t) dma_tile(lds + L_KV + t * 16384, T.KA + (rowbase + kstart + t * 64) * 128 + kvh * 64, T.VA + (rowbase + kstart + t * 64) * 128 + kvh * 64, 128, wave, lane);
    for (int i = threadIdx.x; i < 4 * SW_TABN; i += 512) { const int g = i >> 9, idx = i & 511, dist = SW_I0 - idx;
        ((LAS float*)(lds + L_TAB))[i] = (dist >= 0 && dist < 128) ? LOG2E * T.rel_bias[t5_bucket(dist) * 16 + kvh * 4 + g] : -INFINITY; }
    asm volatile("s_waitcnt vmcnt(0)" ::: "memory"); __syncthreads();
    const int g = wave >> 1, hq = kvh * 4 + g;
    const float sink2 = LOG2E * T.sinks[hq];
#pragma unroll 1
    for (int sub = 0; sub < 2; ++sub) {
        const int qs = (wave & 1) * 64 + sub * 32;
        bf16x8 qr[4]; load_q(qr, T.QA + (rowbase + blk * 128 + qs) * 512 + hq * 64, 512, r32, hi);
        Soft s; soft_init(s);
        const int ta = (qs + 1) >> 6, tb = (qs + 159) >> 6;
        for (int t = (ta > t_lo ? ta : t_lo); t <= tb; ++t) {
            const int dist0 = 128 + qs - 64 * t + r32 - 4 * hi;
            tile_step(s, (lds_cptr)(lds + L_KV + t * 16384), (lds_cptr)(lds + L_KV + t * 16384 + 8192), qr, (lds_cptr)(lds + L_TAB) + g * (SW_TABN * 4) + 4 * (SW_I0 - dist0), lane, r32, hi);
        }
        finish(s, sink2, true, lds + L_OST + wave * OST_BYTES, T.O + (rowbase + blk * 128 + qs) * 1024 + hq * 64, lane, r32, hi);
    }
    __syncthreads();
}
__device__ __forceinline__ void attn_phase(LAS unsigned char* lds, const Tens& T, int vcu, int wave, int lane) {
    const int bh = vcu >> 3, s8 = vcu & 7, b = bh >> 3, h = bh & 7;
    for (int i = threadIdx.x; i < MB_TABN; i += 512) { const int dist = MB_I0 - i; ((LAS float*)(lds + L_TAB))[i] = (dist >= 0) ? LOG2E * T.rel_bias[t5_bucket(dist) * 16 + 8 + h] : -INFINITY; }
    __syncthreads();
    moba_unit(lds, T, b, h, 15 - s8, wave, lane);
    moba_unit(lds, T, b, h, s8, wave, lane);
    swa_unit(lds, T, vcu >> 6, (vcu >> 5) & 1, vcu & 31, wave, lane);
}
}

namespace sa {
__device__ __forceinline__ int t5_bucket(int d) {
    if (d < 16) return d;
    int b = 16;
    b += (d >= 22); b += (d >= 30); b += (d >= 40); b += (d >= 54); b += (d >= 73); b += (d >= 99); b += (d >= 134); b += (d >= 182);
    b += (d >= 246); b += (d >= 332); b += (d >= 450); b += (d >= 609); b += (d >= 825); b += (d >= 1117); b += (d >= 1513);
    return b;
}
__device__ __forceinline__ float wave_max(float v) {
#pragma unroll
    for (int o = 1; o < 64; o <<= 1) v = fmaxf(v, __shfl_xor(v, o));
    return v;
}
__device__ __forceinline__ float bf2f(bf16 v) { return __uint_as_float((unsigned)v << 16); }
__device__ __forceinline__ void load64(const bf16* p, float (&q)[64]) {
#pragma unroll
    for (int i = 0; i < 8; ++i) { const v4u w = *(const v4u*)(p + 8 * i);
        q[8 * i] = __uint_as_float(w.x << 16); q[8 * i + 1] = __uint_as_float(w.x & 0xffff0000u); q[8 * i + 2] = __uint_as_float(w.y << 16); q[8 * i + 3] = __uint_as_float(w.y & 0xffff0000u);
        q[8 * i + 4] = __uint_as_float(w.z << 16); q[8 * i + 5] = __uint_as_float(w.z & 0xffff0000u); q[8 * i + 6] = __uint_as_float(w.w << 16); q[8 * i + 7] = __uint_as_float(w.w & 0xffff0000u); }
}
__device__ __forceinline__ float dot64(const bf16* p, const float (&q)[64]) {
    float a = 0.f;
#pragma unroll
    for (int i = 0; i < 8; ++i) { const v4u w = *(const v4u*)(p + 8 * i);
        a += q[8 * i] * __uint_as_float(w.x << 16); a += q[8 * i + 1] * __uint_as_float(w.x & 0xffff0000u); a += q[8 * i + 2] * __uint_as_float(w.y << 16); a += q[8 * i + 3] * __uint_as_float(w.y & 0xffff0000u);
        a += q[8 * i + 4] * __uint_as_float(w.z << 16); a += q[8 * i + 5] * __uint_as_float(w.z & 0xffff0000u); a += q[8 * i + 6] * __uint_as_float(w.w << 16); a += q[8 * i + 7] * __uint_as_float(w.w & 0xffff0000u); }
    return a;
}
__global__ void __launch_bounds__(256) k_swa(const bf16* QA, const bf16* KA, const bf16* VA, const float* sinks, const float* rel_bias, bf16* O) {
    __shared__ float pl[4][128];
    const int w = threadIdx.x >> 6, lane = threadIdx.x & 63;
    const int gid = blockIdx.x * 4 + w, hq = gid & 7, row = gid >> 3, t = row % SEQ, b = row / SEQ, hk = hq >> 2;
    float q[64]; load64(QA + (size_t)row * 512 + hq * 64, q);
    float sc[2];
#pragma unroll
    for (int i = 0; i < 2; ++i) { const int dist = lane + 64 * i, kp = t - dist; float s = -INFINITY;
        if (kp >= 0) s = dot64(KA + (size_t)(b * SEQ + kp) * 128 + hk * 64, q) + LOG2E * rel_bias[t5_bucket(dist) * 16 + hq];
        sc[i] = s; }
    const float sink = LOG2E * sinks[hq];
    const float m = fmaxf(wave_max(fmaxf(sc[0], sc[1])), sink);
    const float p0 = exp2f(sc[0] - m), p1 = exp2f(sc[1] - m);
    const float den = wave_sum(p0 + p1) + exp2f(sink - m);
    pl[w][lane] = p0 / den; pl[w][lane + 64] = p1 / den;
    __syncthreads();
    float o = 0.f;
    for (int dist = 0; dist < 128; ++dist) { const int kp = t - dist; if (kp >= 0) o += pl[w][dist] * bf2f(VA[(size_t)(b * SEQ + kp) * 128 + hk * 64 + lane]); }
    O[(size_t)row * 1024 + hq * 64 + lane] = (bf16)f2bf(o);
}
__global__ void __launch_bounds__(256) k_moba(const bf16* QB, const bf16* KB, const bf16* VB, const float* kmean, const float* rel_bias, bf16* O) {
    __shared__ float pl[4][1024];
    const int w = threadIdx.x >> 6, lane = threadIdx.x & 63;
    const int gid = blockIdx.x * 4 + w, h = gid & 7, row = gid >> 3, t = row % SEQ, b = row / SEQ, qblk = t >> 8;
    float q[64]; load64(QB + (size_t)row * 512 + h * 64, q);
    float gate = -INFINITY;
    if (lane < qblk) { const float* km = kmean + ((size_t)(b * 16 + lane) * 8 + h) * 64; float a = 0.f;
#pragma unroll
        for (int d = 0; d < 64; ++d) a += q[d] * km[d];
        gate = a; }
    int sel[3]; const int nsel = qblk < 3 ? qblk : 3;
#pragma unroll
    for (int r = 0; r < 3; ++r) { const float mx = wave_max(gate); const unsigned long long bal = __ballot(gate == mx && lane < 16); const int idx = __ffsll((long long)bal) - 1; sel[r] = idx; if (lane == idx) gate = -INFINITY; }
    const int seg_blk[4] = {sel[0], sel[1], sel[2], qblk};
    float sc[16]; float mx = -INFINITY;
#pragma unroll
    for (int seg = 0; seg < 4; ++seg) { const bool seg_valid = (seg == 3) || (seg < nsel); const int blk = seg_blk[seg];
#pragma unroll
        for (int i = 0; i < 4; ++i) { const int kp = blk * 256 + i * 64 + lane; float s = -INFINITY;
            if (seg_valid && kp <= t) s = dot64(KB + (size_t)(b * SEQ + kp) * 512 + h * 64, q) + LOG2E * rel_bias[t5_bucket(t - kp) * 16 + 8 + h];
            sc[seg * 4 + i] = s; mx = fmaxf(mx, s); } }
    mx = wave_max(mx);
    float sum = 0.f;
#pragma unroll
    for (int i = 0; i < 16; ++i) { sc[i] = exp2f(sc[i] - mx); sum += sc[i]; }
    sum = wave_sum(sum); const float inv = 1.f / sum;
#pragma unroll
    for (int i = 0; i < 16; ++i) pl[w][i * 64 + lane] = sc[i] * inv;
    __syncthreads();
    float o = 0.f;
#pragma unroll
    for (int seg = 0; seg < 4; ++seg) { const bool seg_valid = (seg == 3) || (seg < nsel); const int blk = seg_blk[seg];
        if (seg_valid) for (int jj = 0; jj < 256; ++jj) { const int kp = blk * 256 + jj; if (kp <= t) o += pl[w][seg * 256 + jj] * bf2f(VB[(size_t)(b * SEQ + kp) * 512 + h * 64 + lane]); } }
    O[(size_t)row * 1024 + 512 + h * 64 + lane] = (bf16)f2bf(o);
}
}

struct Args { Ptrs p; int ph_lo, ph_hi, li, pad; };
__global__ void __launch_bounds__(NWAVES * 64, 2) mk_fwd(Args args) {
    extern __shared__ __attribute__((aligned(16))) unsigned char lds[];
    Frame F;
    F.lds = (LAS unsigned char*)lds;
    F.MISC = (volatile LAS unsigned*)(F.lds + MISC_OFF);
    F.tid = threadIdx.x; F.lane = F.tid & 63; F.wave = __builtin_amdgcn_readfirstlane(F.tid >> 6);
    F.G = gridDim.x;
    const Ptrs& P = args.p;
    unsigned char* ws = P.ws;
    F.ctl = (gu32*)(ws + WS_CTL);
    for (int u = F.tid; u < 1024 / 4; u += NWAVES * 64) ((LAS unsigned*)(F.lds + LDSCTL_OFF))[u] = 0u;
    __syncthreads();
    XcdBarrier bar = xcd_barrier_post((unsigned*)(F.ctl + CW_BAR) + args.li * XCD_BAR_WORDS, F.MISC + 8);
    const int lo = args.ph_lo, hi = args.ph_hi;
#define IN(k) (lo <= (k) && (k) < hi)
#define BOTH(k) (IN(k) && IN((k) + 1))
    bf16* HA = (bf16*)(ws + WS_HA); bf16* Ob = (bf16*)(ws + WS_O); bf16* MG = (bf16*)(ws + WS_MG); bf16* ACT = (bf16*)(ws + WS_ACT);
    float* mod = (float*)(ws + WS_MOD); float* SS = (float*)(ws + WS_SS); float* SS2 = (float*)(ws + WS_SS2);

    if (IN(0)) { p0_mod_partial(F, P); if (BOTH(0)) xcd_barrier(bar); }
    if (IN(1)) { p1_prologue(F, P); if (BOTH(1)) xcd_barrier(bar); }
    if (IN(2)) {
        p2_bias2(F, P);
        pg8::Gemm g{HA, (const bf16*)(ws + WS_WIN), D, D}; pg8::StaticOrder S; S.init(M, INTOT, F.G, (int)blockIdx.x);
        pg8::EpiProj E{(bf16*)(ws + WS_QA), (bf16*)(ws + WS_KA), (bf16*)(ws + WS_VA), (bf16*)(ws + WS_QB), (bf16*)(ws + WS_KB), (bf16*)(ws + WS_VB), (bf16*)(ws + WS_GA), (bf16*)(ws + WS_GB), (float*)(ws + WS_KMEAN)};
        pg8::gemm_phase<pg8::EpiProj, pg8::StaticOrder, true, true>(F.lds + RING_OFF, g, S, E);
        if (BOTH(2)) xcd_barrier(bar);
    }
    if (IN(3)) {
        const at::Tens T{(const bf16*)(ws + WS_QA), (const bf16*)(ws + WS_KA), (const bf16*)(ws + WS_VA), (const bf16*)(ws + WS_QB), (const bf16*)(ws + WS_KB), (const bf16*)(ws + WS_VB), Ob, (const float*)(ws + WS_KMEAN), P.sinks, P.rel_bias};
        const int bx = blockIdx.x, vcu = (bx % 8) * (F.G / 8) + bx / 8;
        at::attn_phase(F.lds + RING_OFF, T, vcu, F.wave, F.lane);
        if (BOTH(3)) xcd_barrier(bar);
    }
    if (IN(4)) {
        pg8::Gemm g{Ob, (const bf16*)(ws + WS_WAB), 512, D}; pg8::BranchOrder S; S.S.init(M, D, F.G, (int)blockIdx.x);
        pg8::EpiBranch E{(bf16*)ws, (long)(WS_GA / 2), (long)(WS_GB / 2), (long)(WS_HA / 2), (long)(WS_MG / 2)};
        pg8::gemm_phase<pg8::EpiBranch, pg8::BranchOrder, true, true>(F.lds + RING_OFF, g, S, E);
        if (BOTH(4)) xcd_barrier(bar);
    }
    if (IN(5)) {
        pg8::Gemm g{MG, (const bf16*)(ws + WS_WO), D, D}; pg8::StaticOrder S; S.init(M, D, F.G, (int)blockIdx.x);
        pg8::EpiOut E{P.x, P.out, HA, mod, P.n2g, SS};
        pg8::gemm_phase<pg8::EpiOut, pg8::StaticOrder, false, true>(F.lds + RING_OFF, g, S, E);
        if (BOTH(5)) xcd_barrier(bar);
    }
    if (IN(6)) {
        pg8::Gemm g{HA, (const bf16*)(ws + WS_W1), D, D}; pg8::StaticOrder S; S.init(M, FF, F.G, (int)blockIdx.x);
        pg8::EpiMlpIn E{ACT, SS, (const float*)(ws + WS_BIAS2)};
        pg8::gemm_phase<pg8::EpiMlpIn, pg8::StaticOrder, true, true>(F.lds + RING_OFF, g, S, E);
        if (BOTH(6)) xcd_barrier(bar);
    }
    if (IN(7)) {
        pg8::Gemm g{ACT, (const bf16*)(ws + WS_W2), FF, FF}; pg8::StaticOrder S; S.init(M, D, F.G, (int)blockIdx.x);
        pg8::EpiMlpOut E{P.out, mod, SS2};
        pg8::gemm_phase<pg8::EpiMlpOut, pg8::StaticOrder, false, true>(F.lds + RING_OFF, g, S, E);
        if (BOTH(7)) xcd_barrier(bar);
    }
    if (IN(8)) { p8_final_norm(F, P); }
#undef IN
#undef BOTH
}

__global__ void k_dump(const bf16* src, float* out) { const size_t i = (size_t)blockIdx.x * 256 + threadIdx.x; out[i] = __uint_as_float((unsigned)src[i] << 16); }
extern "C" void kernel_launch(void* const* d_in, const int* in_sizes, int n_in, void* d_out, int out_size, void* d_ws, size_t ws_size, hipStream_t stream) {
    static int grid = 0;
    if (grid == 0) {
        if (n_in != 15 || in_sizes[0] != M * D || out_size != M * D || ws_size < WS_END) { fprintf(stderr, "kernel_launch: unexpected shapes (n_in %d, in0 %d, out %d, ws %zu)\n", n_in, n_in > 0 ? in_sizes[0] : -1, out_size, ws_size); grid = -1; return; }
        int dev = 0, cus = 0, per_cu = 0;
        if (hipGetDevice(&dev) != hipSuccess || hipDeviceGetAttribute(&cus, hipDeviceAttributeMultiprocessorCount, dev) != hipSuccess) { grid = -1; return; }
        if (hipFuncSetAttribute((const void*)mk_fwd, hipFuncAttributeMaxDynamicSharedMemorySize, LDS_BYTES) != hipSuccess) { fprintf(stderr, "kernel_launch: hipFuncSetAttribute failed\n"); grid = -1; return; }
        if (hipOccupancyMaxActiveBlocksPerMultiprocessor(&per_cu, (const void*)mk_fwd, NWAVES * 64, LDS_BYTES) != hipSuccess || per_cu < 1) fprintf(stderr, "kernel_launch: occupancy query reports %d\n", per_cu);
        (void)hipGetLastError();
        grid = cus;
        if (grid != 256) { fprintf(stderr, "kernel_launch: built for 256 CUs, device has %d\n", cus); grid = -1; return; }
    }
    if (grid < 0) return;
    (void)hipMemsetAsync((char*)d_ws + WS_CTL, 0, CTL_ZERO_BYTES, stream);
    Args a{};
    a.p.x = (const float*)d_in[0]; a.p.c = (const float*)d_in[1]; a.p.ada_w = (const float*)d_in[2]; a.p.ada_b = (const float*)d_in[3]; a.p.n1g = (const float*)d_in[4]; a.p.n2g = (const float*)d_in[5];
    a.p.w_in = (const float*)d_in[6]; a.p.sinks = (const float*)d_in[7]; a.p.rel_bias = (const float*)d_in[8]; a.p.wa = (const float*)d_in[9]; a.p.wb = (const float*)d_in[10]; a.p.wo = (const float*)d_in[11];
    a.p.w1 = (const float*)d_in[12]; a.p.w2 = (const float*)d_in[13]; a.p.fg = (const float*)d_in[14]; a.p.out = (float*)d_out; a.p.ws = (unsigned char*)d_ws;
    unsigned char* ws = (unsigned char*)d_ws;
#if MK_SIMPLE_ATTN
    a.li = 0; a.pad = 0;
    for (int ph = 0; ph < 3; ph += MK_PH_STEP) { a.ph_lo = ph; a.ph_hi = (ph + MK_PH_STEP < 3) ? ph + MK_PH_STEP : 3; hipLaunchKernelGGL(mk_fwd, dim3(grid), dim3(NWAVES * 64), LDS_BYTES, stream, a); a.li++; }
    hipLaunchKernelGGL(sa::k_swa, dim3(M * 8 / 4), dim3(256), 0, stream, (const bf16*)(ws + WS_QA), (const bf16*)(ws + WS_KA), (const bf16*)(ws + WS_VA), a.p.sinks, a.p.rel_bias, (bf16*)(ws + WS_O));
    hipLaunchKernelGGL(sa::k_moba, dim3(M * 8 / 4), dim3(256), 0, stream, (const bf16*)(ws + WS_QB), (const bf16*)(ws + WS_KB), (const bf16*)(ws + WS_VB), (const float*)(ws + WS_KMEAN), a.p.rel_bias, (bf16*)(ws + WS_O));
#if MK_PROBE_DUMP
    for (int ph = 4; ph < MK_PROBE_DUMP; ph += 1) { a.ph_lo = ph; a.ph_hi = ph + 1; hipLaunchKernelGGL(mk_fwd, dim3(grid), dim3(NWAVES * 64), LDS_BYTES, stream, a); a.li++; }
    hipLaunchKernelGGL(k_dump, dim3(M * D / 256), dim3(256), 0, stream, (const bf16*)(ws + MK_PROBE_SRC), (float*)d_out);
    return;
#endif
    for (int ph = 4; ph < 9; ph += MK_PH_STEP) { a.ph_lo = ph; a.ph_hi = (ph + MK_PH_STEP < 9) ? ph + MK_PH_STEP : 9; hipLaunchKernelGGL(mk_fwd, dim3(grid), dim3(NWAVES * 64), LDS_BYTES, stream, a); a.li++; }
#else
    a.ph_lo = 0; a.ph_hi = 9; a.li = 0; a.pad = 0;
    hipLaunchKernelGGL(mk_fwd, dim3(grid), dim3(NWAVES * 64), LDS_BYTES, stream, a);
#endif
}
```
